# Optimizing an MI355X kernel written in HIP

```python
import jax, jax.numpy as jnp
from jax import lax
import numpy as np

D_MODEL = 1024
BATCH = 16
SEQ = 4096
DEPTH = 2

SSD_EXPAND = 2
SSD_D_INNER = SSD_EXPAND * D_MODEL
SSD_HEAD_DIM = 64
SSD_N_HEADS = SSD_D_INNER // SSD_HEAD_DIM
SSD_N_GROUPS = 4
SSD_HEADS_PER_GROUP = SSD_N_HEADS // SSD_N_GROUPS
SSD_D_STATE = 128
SSD_CONV_WIDTH = 4
SSD_CHUNK = 128
SSD_CONV_DIM = SSD_D_INNER + 2 * SSD_N_GROUPS * SSD_D_STATE
DT_MIN = 1e-3
DT_MAX = 1e-1

SC_WIDTH = D_MODEL
SC_CONV_WIDTH = 3

N_BRANCHES = 2

D_FF = 2816
FFN_CONV_WIDTH = 3

EPS = 1e-6

IN_SPLIT_SIZES = (SSD_D_INNER, SSD_CONV_DIM, SSD_N_HEADS,
                  SC_WIDTH, SC_WIDTH, SC_WIDTH, N_BRANCHES * D_MODEL)
D_IN_PROJ = sum(IN_SPLIT_SIZES)

kernel_name = "hybrid_ssd_shortconv_adaln_block"


def rmsnorm(x, g):
    xf = x.astype(jnp.float32)
    xf = xf * lax.rsqrt(jnp.mean(xf * xf, axis=-1, keepdims=True) + EPS)
    return xf.astype(x.dtype) * g


def grouped_rmsnorm(y, g, n_groups):
    shp = y.shape
    yf = y.astype(jnp.float32).reshape(*shp[:-1], n_groups, shp[-1] // n_groups)
    yf = yf * lax.rsqrt(jnp.mean(yf * yf, axis=-1, keepdims=True) + EPS)
    return yf.reshape(shp) * g


def causal_dwconv(u, w, b=None):
    k_width = w.shape[0]
    seqlen = u.shape[1]
    up = jnp.pad(u, ((0, 0), (k_width - 1, 0), (0, 0)))
    y = up[:, 0:seqlen] * w[0]
    for k in range(1, k_width):
        y = y + up[:, k:k + seqlen] * w[k]
    if b is not None:
        y = y + b
    return y


def ssd_chunked(xh, dt, a, bmat, cmat):
    bsz, seqlen = xh.shape[0], xh.shape[1]
    nc = seqlen // SSD_CHUNK
    L, G, R, P, N = SSD_CHUNK, SSD_N_GROUPS, SSD_HEADS_PER_GROUP, SSD_HEAD_DIM, SSD_D_STATE
    x = (xh * dt[..., None]).reshape(bsz, nc, L, G, R, P)
    adt = jnp.moveaxis((dt * a).reshape(bsz, nc, L, G, R), 2, -1)
    a_cs = jnp.cumsum(adt, axis=-1)
    bc = bmat.reshape(bsz, nc, L, G, N)
    cc = cmat.reshape(bsz, nc, L, G, N)

    causal = jnp.tril(jnp.ones((L, L), dtype=bool))
    decay = jnp.exp(jnp.where(causal, a_cs[..., :, None] - a_cs[..., None, :], -jnp.inf))
    scores = jnp.einsum("bclgn,bcsgn->bcgls", cc, bc)
    m = scores[:, :, :, None] * decay
    y_diag = jnp.einsum("bcgrls,bcsgrp->bclgrp", m, x)

    decay_states = jnp.exp(a_cs[..., -1:] - a_cs)
    states = jnp.einsum("bclgn,bcgrl,bclgrp->bcgrpn", bc, decay_states, x)
    chunk_decay = jnp.exp(a_cs[..., -1])

    def step(h, inp):
        s_c, d_c = inp
        h_new = h * d_c[..., None, None] + s_c
        return h_new, h

    h0 = jnp.zeros((bsz, G, R, P, N), dtype=states.dtype)
    _, prev = lax.scan(step, h0, (jnp.moveaxis(states, 1, 0), jnp.moveaxis(chunk_decay, 1, 0)))
    prev = jnp.moveaxis(prev, 0, 1)

    y_off = jnp.einsum("bclgn,bcgrpn,bcgrl->bclgrp", cc, prev, jnp.exp(a_cs))
    return (y_diag + y_off).reshape(bsz, seqlen, SSD_N_HEADS, P)


def ssd_branch(z, xbc, dt_raw, conv_w, conv_b, dt_bias, a_log, d_skip, norm_g):
    bsz, seqlen = z.shape[0], z.shape[1]
    xbc = jax.nn.silu(causal_dwconv(xbc, conv_w, conv_b))
    gn = SSD_N_GROUPS * SSD_D_STATE
    xs, bm, cm = jnp.split(xbc, [SSD_D_INNER, SSD_D_INNER + gn], axis=-1)
    xh = xs.reshape(bsz, seqlen, SSD_N_HEADS, SSD_HEAD_DIM)
    dt = jax.nn.softplus(dt_raw.astype(jnp.float32) + dt_bias.astype(jnp.float32))
    a = -jnp.exp(a_log.astype(jnp.float32))
    y = ssd_chunked(xh.astype(jnp.float32), dt, a,
                    bm.reshape(bsz, seqlen, SSD_N_GROUPS, SSD_D_STATE).astype(jnp.float32),
                    cm.reshape(bsz, seqlen, SSD_N_GROUPS, SSD_D_STATE).astype(jnp.float32))
    y = y + d_skip.astype(jnp.float32)[:, None] * xh.astype(jnp.float32)
    y = y.reshape(bsz, seqlen, SSD_D_INNER) * jax.nn.silu(z.astype(jnp.float32))
    return grouped_rmsnorm(y, norm_g, SSD_N_GROUPS).astype(z.dtype)


def short_conv_branch(b_gate, c_gate, h, conv_w):
    return b_gate * causal_dwconv(c_gate * h, conv_w)


def hybrid_layer(x, c_act, ada_w, ada_b, mix_pre_g, mix_post_g, w_in,
                 ssd_conv_w, ssd_conv_b, ssd_dt_bias, ssd_a_log, ssd_d, ssd_norm_g,
                 w_ssd_out, sc_conv_w, w_sc_out, w_o,
                 ffn_pre_g, ffn_post_g, w_up, ffn_conv_w, ffn_conv_b, w_down):
    mod = c_act @ ada_w + ada_b
    sh1, sc1, gt1, sh2, sc2, gt2 = [m[:, None, :] for m in jnp.split(mod, 6, axis=-1)]

    h = rmsnorm(x, mix_pre_g) * (1.0 + sc1) + sh1
    proj = h @ w_in
    points, acc = [], 0
    for s in IN_SPLIT_SIZES[:-1]:
        acc += s
        points.append(acc)
    z, xbc, dt_raw, sc_b, sc_c, sc_h, gates = jnp.split(proj, points, axis=-1)
    y_ssd = ssd_branch(z, xbc, dt_raw, ssd_conv_w, ssd_conv_b, ssd_dt_bias,
                       ssd_a_log, ssd_d, ssd_norm_g) @ w_ssd_out
    y_sc = short_conv_branch(sc_b, sc_c, sc_h, sc_conv_w) @ w_sc_out
    g_ssd, g_sc = jnp.split(jax.nn.sigmoid(gates), 2, axis=-1)
    mix = (g_ssd * y_ssd + g_sc * y_sc) @ w_o
    x = x + gt1 * rmsnorm(mix, mix_post_g)

    h = rmsnorm(x, ffn_pre_g) * (1.0 + sc2) + sh2
    u = causal_dwconv(h @ w_up, ffn_conv_w, ffn_conv_b)
    u_gate, u_val = jnp.split(u, 2, axis=-1)
    f = (jax.nn.silu(u_gate) * u_val) @ w_down
    x = x + gt2 * rmsnorm(f, ffn_post_g)
    return x


def setup_inputs(seed: int = 0) -> dict:
    key = jax.random.key(seed)
    ks = jax.random.split(key, 32)
    f32 = jnp.float32

    def dense(k, fan_in, fan_out, scale=1.0):
        return jax.random.normal(k, (DEPTH, fan_in, fan_out), f32) * (scale * fan_in ** -0.5)

    def gain(k, n):
        return 1.0 + 0.05 * jax.random.normal(k, (DEPTH, n), f32)

    def small(k, shape, s=0.02):
        return s * jax.random.normal(k, shape, f32)

    u = jax.random.uniform(ks[8], (DEPTH, SSD_N_HEADS), f32)
    dt0 = jnp.exp(u * (np.log(DT_MAX) - np.log(DT_MIN)) + np.log(DT_MIN))
    dt_bias = dt0 + jnp.log(-jnp.expm1(-dt0))
    a_log = jnp.log(jax.random.uniform(ks[9], (DEPTH, SSD_N_HEADS), f32, 1.0, 16.0))

    return {
        "x": jax.random.normal(ks[0], (BATCH, SEQ, D_MODEL), f32),
        "c": jax.random.normal(ks[1], (BATCH, D_MODEL), f32),
        "ada_w": dense(ks[2], D_MODEL, 6 * D_MODEL, 0.5),
        "ada_b": small(ks[3], (DEPTH, 6 * D_MODEL)),
        "mix_pre_g": gain(ks[4], D_MODEL),
        "mix_post_g": gain(ks[5], D_MODEL),
        "w_in": dense(ks[6], D_MODEL, D_IN_PROJ),
        "ssd_conv_w": jax.random.normal(ks[7], (DEPTH, SSD_CONV_WIDTH, SSD_CONV_DIM), f32) * SSD_CONV_WIDTH ** -0.5,
        "ssd_conv_b": small(ks[10], (DEPTH, SSD_CONV_DIM)),
        "ssd_dt_bias": dt_bias,
        "ssd_a_log": a_log,
        "ssd_d": 1.0 + 0.1 * jax.random.normal(ks[11], (DEPTH, SSD_N_HEADS), f32),
        "ssd_norm_g": gain(ks[12], SSD_D_INNER),
        "w_ssd_out": dense(ks[13], SSD_D_INNER, D_MODEL),
        "sc_conv_w": jax.random.normal(ks[14], (DEPTH, SC_CONV_WIDTH, SC_WIDTH), f32) * SC_CONV_WIDTH ** -0.5,
        "w_sc_out": dense(ks[15], SC_WIDTH, D_MODEL),
        "w_o": dense(ks[16], D_MODEL, D_MODEL),
        "ffn_pre_g": gain(ks[17], D_MODEL),
        "ffn_post_g": gain(ks[18], D_MODEL),
        "w_up": dense(ks[19], D_MODEL, 2 * D_FF),
        "ffn_conv_w": jax.random.normal(ks[20], (DEPTH, FFN_CONV_WIDTH, 2 * D_FF), f32) * FFN_CONV_WIDTH ** -0.5,
        "ffn_conv_b": small(ks[21], (DEPTH, 2 * D_FF)),
        "w_down": dense(ks[22], D_FF, D_MODEL),
    }


def reference(x, c, ada_w, ada_b, mix_pre_g, mix_post_g, w_in,
              ssd_conv_w, ssd_conv_b, ssd_dt_bias, ssd_a_log, ssd_d, ssd_norm_g,
              w_ssd_out, sc_conv_w, w_sc_out, w_o,
              ffn_pre_g, ffn_post_g, w_up, ffn_conv_w, ffn_conv_b, w_down):
    c_act = jax.nn.silu(c)
    for i in range(DEPTH):
        x = hybrid_layer(x, c_act, ada_w[i], ada_b[i], mix_pre_g[i], mix_post_g[i], w_in[i],
                         ssd_conv_w[i], ssd_conv_b[i], ssd_dt_bias[i], ssd_a_log[i], ssd_d[i],
                         ssd_norm_g[i], w_ssd_out[i], sc_conv_w[i], w_sc_out[i], w_o[i],
                         ffn_pre_g[i], ffn_post_g[i], w_up[i], ffn_conv_w[i], ffn_conv_b[i],
                         w_down[i])
    return x
```

```cpp
#include <hip/hip_runtime.h>
#include <hip/hip_cooperative_groups.h>
#include <cstdio>
namespace cg = cooperative_groups;


typedef unsigned short bf16_t;
typedef short bf16x8 __attribute__((ext_vector_type(8)));
typedef float f32x4 __attribute__((ext_vector_type(4)));
typedef float f32x2 __attribute__((ext_vector_type(2)));
typedef unsigned u32x2 __attribute__((ext_vector_type(2)));
typedef unsigned u32x4 __attribute__((ext_vector_type(4)));
#define LAS __attribute__((address_space(3)))

constexpr int DM = 1024, SEQ = 4096, NBATCH = 16, DEPTH = 2;
constexpr int DI = 2048, NH = 32, NG = 4, DS = 128, CONVD = 3072, LCH = 128, NCH = 32, DFF = 2816;
constexpr int DINP = 10272, NPI = 10496;
#ifndef MK_NGRP
#define MK_NGRP 8
#endif
constexpr int NGRP = MK_NGRP, GBLK = 256 / NGRP, XPG = 8 / NGRP;
constexpr int SB = NBATCH / (2 * NGRP), MS = SB * SEQ, NSL = NBATCH / SB;
constexpr float EPS = 1e-6f;
constexpr int LDS_BYTES = 131072 + 16;

constexpr size_t E_WIN = 0, E_WSSD = (size_t)NPI * 1024, E_WSC = E_WSSD + 1024 * 2048, E_WO = E_WSC + 1024 * 1024,
                 E_WUP = E_WO + 1024 * 1024, E_WDN = E_WUP + (size_t)5632 * 1024, E_WLAYER = E_WDN + (size_t)1024 * 2816;
constexpr size_t OFF_WT = 0;
constexpr size_t OFF_MOD = OFF_WT + 2 * E_WLAYER * 2;
constexpr size_t OFF_BAR = OFF_MOD + 2 * 16 * 6144 * 4;
constexpr size_t BAR_BYTES = 8 * 16384;
constexpr size_t OFF_GRP = OFF_BAR + BAR_BYTES;
constexpr size_t OFF_CD = 0;
constexpr size_t OFF_H = OFF_CD + SB * 32 * 32 * 4;
constexpr size_t OFF_AR = OFF_H + (size_t)MS * 1024 * 2;
constexpr size_t OFF_Z = OFF_AR;
constexpr size_t OFF_XBC = OFF_Z + (size_t)MS * 2048 * 2;
constexpr size_t OFF_SCB = OFF_XBC + (size_t)MS * 3072 * 2;
constexpr size_t OFF_CHB = OFF_SCB + (size_t)MS * 1024 * 2;
constexpr size_t OFF_G = OFF_CHB + (size_t)MS * 1024 * 2;
constexpr size_t OFF_DT = OFF_G + (size_t)MS * 2048 * 2;
constexpr size_t OFF_YP = OFF_DT + (size_t)MS * 32 * 4;
constexpr size_t OFF_ST = OFF_YP + (size_t)MS * 2048 * 2;
constexpr size_t OFF_END1 = OFF_ST + (size_t)SB * 32 * 32 * 8192 * 2;
constexpr size_t OFF_SSDN = OFF_YP;
constexpr size_t OFF_SCPRE = OFF_SCB;
constexpr size_t OFF_T1 = OFF_CHB;
constexpr size_t OFF_MIXIN = OFF_XBC + (size_t)MS * 1024 * 2;
constexpr size_t OFF_MIX = OFF_Z;
constexpr size_t OFF_U = OFF_AR;
constexpr size_t OFF_ACT = OFF_U + (size_t)MS * 5632 * 2;
constexpr size_t OFF_F = OFF_ACT + (size_t)MS * 2816 * 2;
constexpr size_t OFF_END2 = OFF_F + (size_t)MS * 1024 * 2;
constexpr size_t GSTRIDE = OFF_END1 > OFF_END2 ? OFF_END1 : OFF_END2;
constexpr size_t WS_NEED = OFF_GRP + NGRP * GSTRIDE;
static_assert(OFF_MIXIN + (size_t)MS * 1024 * 2 <= OFF_SCB, "T1 + MIXIN must fit inside the dead XBC region");

struct Params {
    const float* in[23];
    float* out;
    unsigned char* ws;
    int ph_lo, ph_hi;
};

typedef __bf16 bf16x2_t __attribute__((ext_vector_type(2)));
__device__ __forceinline__ unsigned pk_bf16(float lo, float hi) { const f32x2 v = {lo, hi}; const bf16x2_t b = __builtin_convertvector(v, bf16x2_t); return __builtin_bit_cast(unsigned, b); }
__device__ __forceinline__ float bf_lo(unsigned u) { return __uint_as_float(u << 16); }
__device__ __forceinline__ float bf_hi(unsigned u) { return __uint_as_float(u & 0xffff0000u); }
__device__ __forceinline__ float fsigmoid(float x) { return __builtin_amdgcn_rcpf(1.0f + __expf(-x)); }
__device__ __forceinline__ float fsilu(float x) { return x * fsigmoid(x); }
__device__ __forceinline__ float wave_sum(float v) {
#pragma unroll
    for (int o = 32; o >= 1; o >>= 1) v += __shfl_xor(v, o);
    return v;
}
__device__ __forceinline__ int perm32(int rho) { const int n = rho >> 4, i = rho & 15; return 8 * (i >> 2) + 4 * n + (i & 3); }
__device__ __forceinline__ int inproj_src(int L) {
    if (L < 5120) return L;
    if (L < 6144) return 5152 + (L - 5120);
    if (L < 8192) { const int q = L - 6144, j = q >> 3, e = q & 7; return (e < 4 ? 6176 : 7200) + 4 * j + (e & 3); }
    if (L < 10240) return 8224 + (L - 8192);
    if (L < 10272) return 5120 + (L - 10240);
    return -1;
}

namespace pg8 {
constexpr int BM = 256, BK = 64, HALF = 128, HTB = HALF * BK * 2, NXCD = 8, WGM = 4;
__device__ __forceinline__ int lds_byte(int r, int c) { const int st = (r >> 4) * 2 + (c >> 5), rr = r & 15, cc = c & 31, ob = rr * 64 + cc * 2; return st * 1024 + (ob ^ (((ob >> 9) & 1) << 5)); }
__device__ __forceinline__ void stage_rc(int b, int& R, int& C) { const int st = b / 1024, sb = b % 1024, swz = sb ^ (((sb >> 9) & 1) << 5); R = (st >> 1) * 16 + swz / 64; C = (st & 1) * 32 + (swz % 64) / 2; }
struct Unit { int pm, pn; };
struct Gemm { const bf16_t* A; const bf16_t* Bt; int M, N, K; };
struct StaticOrder {
    int nM, nN, nwg, G, c;
    static constexpr int NX = XPG;
    __device__ void init(int M, int N, int G_, int c_) { nM = M / BM; nN = N / BM; nwg = nM * nN; G = G_; c = c_; }
    __device__ bool next(int i, Unit& u) const {
        const long L = (long)i * G + c; if (L >= nwg) return false;
        int wgid = (int)L; { const int q = nwg / NX, r = nwg % NX, xcd = wgid % NX, off = wgid / NX; wgid = (xcd < r ? xcd * (q + 1) : r * (q + 1) + (xcd - r) * q) + off; }
        const int nig = WGM * nN, gid = wgid / nig, fm = gid * WGM, gsz = (nM - fm) < WGM ? (nM - fm) : WGM;
        u.pm = fm + ((wgid % nig) % gsz); u.pn = (wgid % nig) / gsz; return true;
    }
};

template <class Epi, bool OVL = false>
__device__ __forceinline__ void gemm_phase(LAS unsigned char* lds, const Gemm g, const StaticOrder& S, const Epi& E) {
    int tid_ = threadIdx.x; asm volatile("" : "+v"(tid_));
    const int tid = tid_, wid = __builtin_amdgcn_readfirstlane(tid >> 6), lane = tid & 63, wr = wid >> 2, wc = wid & 3, fr = lane & 15, fq = lane >> 4;
    const int K = g.K, nt = K / BK;
    int voffA[2], voffB[2];
#pragma unroll
    for (int i = 0; i < 2; ++i) { int R, C; stage_rc(tid * 16 + i * 8192, R, C); voffB[i] = (R * K + C) * 2; voffA[i] = OVL ? ((62 * (R >> 6) + (R & 63) - 2) * K + C) * 2 : voffB[i]; }
    const size_t kstep = (size_t)(BK * 2);
    const size_t hstep = (size_t)HALF * K * 2;
    const size_t tstep = 2 * hstep;
    const size_t hstepA = OVL ? (size_t)124 * K * 2 : hstep, tstepA = 2 * hstepA;
    const unsigned ldsw = (unsigned)wid * 1024u;
    const int aoff = lds_byte(wr * 64 + fr, fq * 8), boff = lds_byte(wc * 32 + fr, fq * 8);
#define PG8_SA(b, h) (((b) * 2 + (h)) * HTB)
#define PG8_SB(b, h) ((4 + (b) * 2 + (h)) * HTB)
#define PG8_STAGEX(bufoff, gbase, voff) do { _Pragma("unroll") for (int _i = 0; _i < 2; ++_i) \
        __builtin_amdgcn_global_load_lds((const unsigned*)((const char*)(gbase) + (long)(voff)[_i]), (LAS unsigned*)(lds + (bufoff) + ldsw + _i * 8192), 16, 0, 0); } while (0)
#define PG8_STAGEA(bufoff, gbase) PG8_STAGEX(bufoff, gbase, voffA)
#define PG8_STAGEB(bufoff, gbase) PG8_STAGEX(bufoff, gbase, voffB)
#define PG8_LDA(dst, b, h) do { _Pragma("unroll") for (int m = 0; m < 4; ++m) _Pragma("unroll") for (int k = 0; k < 2; ++k) dst[m][k] = *(const LAS bf16x8*)(lds + PG8_SA(b, h) + aoff + m * 2048 + k * 1024); } while (0)
#define PG8_LDB(dst, b, h) do { _Pragma("unroll") for (int n = 0; n < 2; ++n) _Pragma("unroll") for (int k = 0; k < 2; ++k) dst[n][k] = *(const LAS bf16x8*)(lds + PG8_SB(b, h) + boff + n * 2048 + k * 1024); } while (0)
#define PG8_MMA(ai, bj, At, Bt) do { __builtin_amdgcn_s_setprio(1); _Pragma("unroll") for (int m = 0; m < 4; ++m) _Pragma("unroll") for (int n = 0; n < 2; ++n) _Pragma("unroll") for (int k = 0; k < 2; ++k) \
        acc[ai][bj][m][n] = __builtin_amdgcn_mfma_f32_16x16x32_bf16(Bt[n][k], At[m][k], acc[ai][bj][m][n], 0, 0, 0); __builtin_amdgcn_s_setprio(0); } while (0)
#define PG8_WAIT_V(n) asm volatile("s_waitcnt vmcnt(" #n ")" ::: "memory")
#define PG8_WAIT_L(n) asm volatile("s_waitcnt lgkmcnt(" #n ")" ::: "memory")
#define PG8_BAR __builtin_amdgcn_s_barrier()
#define PG8_SCHED __builtin_amdgcn_sched_barrier(0)
    Unit cur, nxt; int ui = 0;
    if (!S.next(0, cur)) return;
    f32x4 acc[2][2][4][2];
#pragma unroll
    for (int a = 0; a < 2; ++a)
#pragma unroll
        for (int b = 0; b < 2; ++b)
#pragma unroll
            for (int m = 0; m < 4; ++m)
#pragma unroll
                for (int n = 0; n < 2; ++n) acc[a][b][m][n] = (f32x4){0.f, 0.f, 0.f, 0.f};
    bf16x8 At[4][2], B0[2][2], B1[2][2];
    const char* cA = (const char*)g.A + (size_t)cur.pm * tstepA; const char* cB = (const char*)g.Bt + (size_t)cur.pn * tstep;
    PG8_STAGEB(PG8_SB(0, 0), cB); PG8_STAGEA(PG8_SA(0, 0), cA); PG8_STAGEB(PG8_SB(0, 1), cB + hstep); PG8_STAGEA(PG8_SA(0, 1), cA + hstepA);
    if (wr == 1) PG8_BAR;
    PG8_WAIT_V(4); PG8_BAR;
    PG8_STAGEB(PG8_SB(1, 0), cB + kstep); PG8_STAGEA(PG8_SA(1, 0), cA + kstep); PG8_STAGEB(PG8_SB(1, 1), cB + hstep + kstep);
    PG8_WAIT_V(6); PG8_BAR;
    for (;;) {
        const bool has_next = S.next(ui + 1, nxt);
        const char* nA = has_next ? (const char*)g.A + (size_t)nxt.pm * tstepA : cA; const char* nB = has_next ? (const char*)g.Bt + (size_t)nxt.pn * tstep : cB;
        for (int t = 0; t < nt; t += 2) {
            const bool last = (t == nt - 2);
            const char* a1 = cA + (size_t)(t + 1) * kstep;
            const char* a2 = last ? nA : cA + (size_t)(t + 2) * kstep; const char* b2 = last ? nB : cB + (size_t)(t + 2) * kstep;
            const char* a3 = a2 + kstep; const char* b3 = b2 + kstep;
            PG8_LDB(B0, 0, 0); PG8_SCHED; PG8_LDA(At, 0, 0); PG8_STAGEA(PG8_SA(1, 1), a1 + hstepA);
            PG8_WAIT_L(8); PG8_BAR; PG8_WAIT_L(0); PG8_MMA(0, 0, At, B0); PG8_BAR; PG8_SCHED;
            PG8_LDB(B1, 0, 1); PG8_STAGEB(PG8_SB(0, 0), b2);
            PG8_BAR; PG8_WAIT_L(0); PG8_MMA(0, 1, At, B1); PG8_BAR;
            PG8_LDA(At, 0, 1); PG8_STAGEA(PG8_SA(0, 0), a2);
            PG8_BAR; PG8_WAIT_L(0); PG8_MMA(1, 0, At, B0); PG8_BAR; PG8_SCHED;
            PG8_STAGEB(PG8_SB(0, 1), b2 + hstep);
            PG8_WAIT_V(6); PG8_BAR; PG8_MMA(1, 1, At, B1); PG8_BAR;
            PG8_LDB(B0, 1, 0); PG8_SCHED; PG8_LDA(At, 1, 0); PG8_STAGEA(PG8_SA(0, 1), a2 + hstepA);
            PG8_WAIT_L(8); PG8_BAR; PG8_WAIT_L(0); PG8_MMA(0, 0, At, B0); PG8_BAR; PG8_SCHED;
            PG8_LDB(B1, 1, 1); PG8_STAGEB(PG8_SB(1, 0), b3);
            PG8_BAR; PG8_WAIT_L(0); PG8_MMA(0, 1, At, B1); PG8_BAR;
            PG8_LDA(At, 1, 1); PG8_STAGEA(PG8_SA(1, 0), a3);
            PG8_BAR; PG8_WAIT_L(0); PG8_MMA(1, 0, At, B0); PG8_BAR; PG8_SCHED;
            PG8_STAGEB(PG8_SB(1, 1), b3 + hstep);
            PG8_WAIT_V(6); PG8_BAR; PG8_MMA(1, 1, At, B1); PG8_BAR;
        }
        E(acc, cur, wr, wc, fr, fq);
        if (!has_next) break;
#pragma unroll
        for (int a = 0; a < 2; ++a)
#pragma unroll
            for (int b = 0; b < 2; ++b)
#pragma unroll
                for (int m = 0; m < 4; ++m)
#pragma unroll
                    for (int n = 0; n < 2; ++n) acc[a][b][m][n] = (f32x4){0.f, 0.f, 0.f, 0.f};
        cur = nxt; cA = nA; cB = nB; ++ui;
    }
    PG8_WAIT_V(0);
    if (wr == 0) PG8_BAR;
    PG8_BAR;
#undef PG8_SA
#undef PG8_SB
#undef PG8_STAGEX
#undef PG8_STAGEA
#undef PG8_STAGEB
#undef PG8_LDA
#undef PG8_LDB
#undef PG8_MMA
#undef PG8_WAIT_V
#undef PG8_WAIT_L
#undef PG8_BAR
#undef PG8_SCHED
}
}

struct EpiF32 {
    float* C; int ld;
    __device__ __forceinline__ void operator()(const f32x4 (&acc)[2][2][4][2], const pg8::Unit& u, int wr, int wc, int fr, int fq) const {
        const int row0 = u.pm * 256 + wr * 64 + fr, col0 = u.pn * 256 + wc * 32 + 4 * fq;
#pragma unroll
        for (int ai = 0; ai < 2; ++ai)
#pragma unroll
            for (int m = 0; m < 4; ++m) { float* rowp = C + (size_t)(row0 + ai * 128 + m * 16) * ld + col0;
#pragma unroll
                for (int bj = 0; bj < 2; ++bj)
#pragma unroll
                    for (int n = 0; n < 2; ++n) *(f32x4*)(rowp + bj * 128 + n * 16) = acc[ai][bj][m][n]; }
    }
};
struct EpiGate1 {
    bf16_t* C; const bf16_t* G;
    __device__ __forceinline__ void operator()(const f32x4 (&acc)[2][2][4][2], const pg8::Unit& u, int wr, int wc, int fr, int fq) const {
        const int row0 = u.pm * 256 + wr * 64 + fr, col0 = u.pn * 256 + wc * 32 + 8 * fq;
#pragma unroll
        for (int ai = 0; ai < 2; ++ai)
#pragma unroll
            for (int m = 0; m < 4; ++m) { const size_t r = (size_t)(row0 + ai * 128 + m * 16);
#pragma unroll
                for (int bj = 0; bj < 2; ++bj) { const int c = col0 + bj * 128; const u32x4 gv = *(const u32x4*)(G + r * 2048 + c); const f32x4 a0 = acc[ai][bj][m][0], a1 = acc[ai][bj][m][1];
                    u32x4 w; w.x = pk_bf16(a0[0] * bf_lo(gv.x), a0[1] * bf_hi(gv.x)); w.y = pk_bf16(a0[2] * bf_lo(gv.y), a0[3] * bf_hi(gv.y));
                    w.z = pk_bf16(a1[0] * bf_lo(gv.z), a1[1] * bf_hi(gv.z)); w.w = pk_bf16(a1[2] * bf_lo(gv.w), a1[3] * bf_hi(gv.w));
                    *(u32x4*)(C + r * 1024 + c) = w; } }
    }
};
struct EpiGate2 {
    bf16_t* O; const bf16_t* T1; const bf16_t* G;
    __device__ __forceinline__ void operator()(const f32x4 (&acc)[2][2][4][2], const pg8::Unit& u, int wr, int wc, int fr, int fq) const {
        const int row0 = u.pm * 256 + wr * 64 + fr, col0 = u.pn * 256 + wc * 32 + 8 * fq;
#pragma unroll
        for (int ai = 0; ai < 2; ++ai)
#pragma unroll
            for (int m = 0; m < 4; ++m) { const size_t r = (size_t)(row0 + ai * 128 + m * 16);
#pragma unroll
                for (int bj = 0; bj < 2; ++bj) { const int c = col0 + bj * 128; const u32x4 gv = *(const u32x4*)(G + r * 2048 + c); const u32x4 tv = *(const u32x4*)(T1 + r * 1024 + c);
                    const f32x4 a0 = acc[ai][bj][m][0], a1 = acc[ai][bj][m][1];
                    u32x4 w; w.x = pk_bf16(bf_lo(tv.x) + a0[0] * bf_lo(gv.x), bf_hi(tv.x) + a0[1] * bf_hi(gv.x)); w.y = pk_bf16(bf_lo(tv.y) + a0[2] * bf_lo(gv.y), bf_hi(tv.y) + a0[3] * bf_hi(gv.y));
                    w.z = pk_bf16(bf_lo(tv.z) + a1[0] * bf_lo(gv.z), bf_hi(tv.z) + a1[1] * bf_hi(gv.z)); w.w = pk_bf16(bf_lo(tv.w) + a1[2] * bf_lo(gv.w), bf_hi(tv.w) + a1[3] * bf_hi(gv.w));
                    *(u32x4*)(O + r * 1024 + c) = w; } }
    }
};
struct EpiBf16 {
    bf16_t* O; int ld;
    __device__ __forceinline__ void operator()(const f32x4 (&acc)[2][2][4][2], const pg8::Unit& u, int wr, int wc, int fr, int fq) const {
        const int row0 = u.pm * 256 + wr * 64 + fr, col0 = u.pn * 256 + wc * 32 + 8 * fq;
#pragma unroll
        for (int ai = 0; ai < 2; ++ai)
#pragma unroll
            for (int m = 0; m < 4; ++m) { bf16_t* rowp = O + (size_t)(row0 + ai * 128 + m * 16) * ld + col0;
#pragma unroll
                for (int bj = 0; bj < 2; ++bj) { const f32x4 a0 = acc[ai][bj][m][0], a1 = acc[ai][bj][m][1];
                    u32x4 w; w.x = pk_bf16(a0[0], a0[1]); w.y = pk_bf16(a0[2], a0[3]); w.z = pk_bf16(a1[0], a1[1]); w.w = pk_bf16(a1[2], a1[3]);
                    *(u32x4*)(rowp + bj * 128) = w; } }
    }
};
template <int N> __device__ __forceinline__ float dpp_ror(float v) { return __builtin_bit_cast(float, __builtin_amdgcn_update_dpp(0, __builtin_bit_cast(int, v), 0x120 + N, 0xF, 0xF, false)); }
struct EpiFfn {
    bf16_t* ACT; const float* fw; const float* fb;
    __device__ __forceinline__ void operator()(const f32x4 (&acc)[2][2][4][2], const pg8::Unit& u, int wr, int wc, int fr, int fq) const {
#pragma unroll
        for (int bj = 0; bj < 2; ++bj) {
            const int ch0 = 4 * (32 * u.pn + 16 * bj + 4 * wc + fq);
            const f32x4 wg0 = *(const f32x4*)(fw + ch0), wg1 = *(const f32x4*)(fw + 5632 + ch0), wg2 = *(const f32x4*)(fw + 2 * 5632 + ch0), bg = *(const f32x4*)(fb + ch0);
            const f32x4 wv0 = *(const f32x4*)(fw + 2816 + ch0), wv1 = *(const f32x4*)(fw + 5632 + 2816 + ch0), wv2 = *(const f32x4*)(fw + 2 * 5632 + 2816 + ch0), bv = *(const f32x4*)(fb + 2816 + ch0);
#pragma unroll
            for (int ai = 0; ai < 2; ++ai) {
                const int rowblk = 248 * u.pm + 124 * ai + 62 * wr - 2;
                f32x4 g1p = (f32x4){0.f, 0.f, 0.f, 0.f}, g2p = g1p, v1p = g1p, v2p = g1p;
#pragma unroll
                for (int m = 0; m < 4; ++m) {
                    const f32x4 cg = acc[ai][bj][m][0], cv = acc[ai][bj][m][1];
                    f32x4 g1c, g2c, v1c, v2c;
#pragma unroll
                    for (int e = 0; e < 4; ++e) { g1c[e] = dpp_ror<1>(cg[e]); g2c[e] = dpp_ror<2>(cg[e]); v1c[e] = dpp_ror<1>(cv[e]); v2c[e] = dpp_ror<2>(cv[e]); }
                    const int rho = 16 * m + fr, grow = rowblk + rho, pos = grow & 4095;
                    f32x4 pg1, pg2, pv1, pv2;
#pragma unroll
                    for (int e = 0; e < 4; ++e) { pg1[e] = fr >= 1 ? g1c[e] : g1p[e]; pg2[e] = fr >= 2 ? g2c[e] : g2p[e]; pv1[e] = fr >= 1 ? v1c[e] : v1p[e]; pv2[e] = fr >= 2 ? v2c[e] : v2p[e]; }
                    if (__builtin_amdgcn_ballot_w64(pos <= 1) != 0ull) {
#pragma unroll
                        for (int e = 0; e < 4; ++e) { if (pos == 0) { pg1[e] = 0.f; pv1[e] = 0.f; } if (pos <= 1) { pg2[e] = 0.f; pv2[e] = 0.f; } } }
                    float o[4];
#pragma unroll
                    for (int e = 0; e < 4; ++e) { const float ug = bg[e] + wg0[e] * pg2[e] + wg1[e] * pg1[e] + wg2[e] * cg[e]; const float uv = bv[e] + wv0[e] * pv2[e] + wv1[e] * pv1[e] + wv2[e] * cv[e]; o[e] = fsilu(ug) * uv; }
                    if (rho >= 2 && grow < MS) { u32x2 w; w.x = pk_bf16(o[0], o[1]); w.y = pk_bf16(o[2], o[3]); *(u32x2*)(ACT + (size_t)grow * 2816 + ch0) = w; }
                    g1p = g1c; g2p = g2c; v1p = v1c; v2p = v2c;
                }
            }
        }
    }
};
struct EpiInProj {
    bf16_t *Z, *XBC, *SCB, *CHB, *G; float* DT; const float* dt_bias;
    __device__ __forceinline__ void operator()(const f32x4 (&acc)[2][2][4][2], const pg8::Unit& u, int wr, int wc, int fr, int fq) const {
        const int row0 = u.pm * 256 + wr * 64 + fr, col0 = u.pn * 256 + wc * 32 + 8 * fq; const int pn = u.pn;
#pragma unroll
        for (int ai = 0; ai < 2; ++ai)
#pragma unroll
            for (int m = 0; m < 4; ++m) { const size_t r = (size_t)(row0 + ai * 128 + m * 16);
#pragma unroll
                for (int bj = 0; bj < 2; ++bj) { const int c = col0 + bj * 128; f32x4 a0 = acc[ai][bj][m][0], a1 = acc[ai][bj][m][1];
                    if (pn < 8) {
#pragma unroll
                        for (int e = 0; e < 4; ++e) { a0[e] = fsilu(a0[e]); a1[e] = fsilu(a1[e]); }
                        u32x4 w; w.x = pk_bf16(a0[0], a0[1]); w.y = pk_bf16(a0[2], a0[3]); w.z = pk_bf16(a1[0], a1[1]); w.w = pk_bf16(a1[2], a1[3]);
                        __builtin_nontemporal_store(w, (u32x4*)(Z + r * 2048 + c));
                    } else if (pn < 20) {
                        u32x4 w; w.x = pk_bf16(a0[0], a0[1]); w.y = pk_bf16(a0[2], a0[3]); w.z = pk_bf16(a1[0], a1[1]); w.w = pk_bf16(a1[2], a1[3]);
                        *(u32x4*)(XBC + r * 3072 + (c - 2048)) = w;
                    } else if (pn < 24) {
                        u32x4 w; w.x = pk_bf16(a0[0], a0[1]); w.y = pk_bf16(a0[2], a0[3]); w.z = pk_bf16(a1[0], a1[1]); w.w = pk_bf16(a1[2], a1[3]);
                        *(u32x4*)(SCB + r * 1024 + (c - 5120)) = w;
                    } else if (pn < 32) {
                        u32x2 w; w.x = pk_bf16(a0[0] * a1[0], a0[1] * a1[1]); w.y = pk_bf16(a0[2] * a1[2], a0[3] * a1[3]);
                        *(u32x2*)(CHB + r * 1024 + ((c - 6144) >> 1)) = w;
                    } else if (pn < 40) {
#pragma unroll
                        for (int e = 0; e < 4; ++e) { a0[e] = fsigmoid(a0[e]); a1[e] = fsigmoid(a1[e]); }
                        u32x4 w; w.x = pk_bf16(a0[0], a0[1]); w.y = pk_bf16(a0[2], a0[3]); w.z = pk_bf16(a1[0], a1[1]); w.w = pk_bf16(a1[2], a1[3]);
                        __builtin_nontemporal_store(w, (u32x4*)(G + r * 2048 + (c - 8192)));
                    } else {
                        if (bj == 0 && wc == 0) { const int h0 = 8 * fq; f32x4 o0, o1;
#pragma unroll
                            for (int e = 0; e < 4; ++e) { float x0 = a0[e] + dt_bias[h0 + e], x1 = a1[e] + dt_bias[h0 + 4 + e];
                                o0[e] = x0 > 20.f ? x0 : log1pf(expf(x0)); o1[e] = x1 > 20.f ? x1 : log1pf(expf(x1)); }
                            *(f32x4*)(DT + r * 32 + h0) = o0; *(f32x4*)(DT + r * 32 + h0 + 4) = o1; }
                    } } }
    }
};

struct CvtTile { const float* W; bf16_t* Wt; int K, N, kind, tile; };
__device__ __forceinline__ void convert_load(const CvtTile& c, float (&v)[8], int tid) {
    const int ntk = c.K >> 6; const int tn = c.tile / ntk, tk = c.tile - tn * ntk; const int n0 = tn * 64, k0 = tk * 64;
    const int nl = tid & 63, nphys = n0 + nl; int L = nphys;
    if (c.kind >= 1) L = (nphys & ~31) + perm32(nphys & 31);
    int src = (c.kind == 2) ? inproj_src(L) : L;
    if (c.kind == 3) { const int j = L >> 3, e = L & 7; src = (e < 4 ? 0 : 2816) + 4 * j + (e & 3); }
#pragma unroll
    for (int i = 0; i < 8; ++i) { const int k = (tid >> 6) + 8 * i; v[i] = (src >= 0 && src < c.N) ? c.W[(size_t)(k0 + k) * c.N + src] : 0.f; }
}
__device__ __forceinline__ void convert_stash(const float (&v)[8], float* tl, int tid) {
    const int nl = tid & 63;
#pragma unroll
    for (int i = 0; i < 8; ++i) { const int k = (tid >> 6) + 8 * i; tl[nl * 65 + k] = v[i]; }
}
__device__ __forceinline__ void convert_store(const CvtTile& c, const float* tl, int tid) {
    const int ntk = c.K >> 6; const int tn = c.tile / ntk, tk = c.tile - tn * ntk; const int n0 = tn * 64, k0 = tk * 64;
    const int nl = tid >> 3, k8 = (tid & 7) * 8; const float* s = tl + nl * 65 + k8;
    u32x4 w; w.x = pk_bf16(s[0], s[1]); w.y = pk_bf16(s[2], s[3]); w.z = pk_bf16(s[4], s[5]); w.w = pk_bf16(s[6], s[7]);
    *(u32x4*)(c.Wt + (size_t)(n0 + nl) * c.K + k0 + k8) = w;
}

__device__ __forceinline__ void mod_item(const Params& p, int item, float* sm) {
    int tid_ = threadIdx.x; asm volatile("" : "+v"(tid_));
    const int tid = tid_; const int l = item / 96, cgp = item - l * 96; const int kq = tid >> 6, j = tid & 63, col = cgp * 64 + j;
    float* cact = sm;
    float* red = sm + 16 * 1024;
    const float* c = p.in[1];
    for (int i = tid; i < 16 * 1024; i += 512) cact[(i & 1023) * 16 + (i >> 10)] = fsilu(c[i]);
    __syncthreads();
    const float* W = p.in[2] + (size_t)l * 1024 * 6144;
    float acc[16];
#pragma unroll
    for (int b = 0; b < 16; ++b) acc[b] = 0.f;
#pragma unroll 1
    for (int k0 = kq * 128; k0 < kq * 128 + 128; k0 += 16) {
        float wv[16];
#pragma unroll
        for (int u = 0; u < 16; ++u) wv[u] = W[(size_t)(k0 + u) * 6144 + col];
#pragma unroll
        for (int u = 0; u < 16; ++u) {
#pragma unroll
            for (int b4 = 0; b4 < 4; ++b4) { const f32x4 cv = *(const f32x4*)(cact + (k0 + u) * 16 + 4 * b4);
                acc[4 * b4 + 0] += cv[0] * wv[u]; acc[4 * b4 + 1] += cv[1] * wv[u]; acc[4 * b4 + 2] += cv[2] * wv[u]; acc[4 * b4 + 3] += cv[3] * wv[u]; } }
    }
#pragma unroll
    for (int b = 0; b < 16; ++b) red[(kq * 16 + b) * 64 + j] = acc[b];
    __syncthreads();
    float* mod = (float*)(p.ws + OFF_MOD) + (size_t)l * 16 * 6144;
    const float bias = p.in[3][l * 6144 + col];
#pragma unroll
    for (int bb = 0; bb < 2; ++bb) { const int b = kq * 2 + bb; float s = bias;
#pragma unroll
        for (int q = 0; q < 8; ++q) s += red[(q * 16 + b) * 64 + j];
        mod[b * 6144 + col] = s; }
    __syncthreads();
}

__device__ __forceinline__ CvtTile prep_tile(const Params& p, int l, int t) {
    constexpr int T_WIN = (NPI / 64) * 16, T_WSSD = 16 * 32, T_WSC = 16 * 16, T_WO = 16 * 16, T_WUP = 88 * 16;
    bf16_t* wt = (bf16_t*)(p.ws + OFF_WT) + (size_t)l * E_WLAYER;
    if (t < T_WIN) return CvtTile{p.in[6] + (size_t)l * 1024 * DINP, wt + E_WIN, 1024, DINP, 2, t};
    t -= T_WIN;
    if (t < T_WSSD) return CvtTile{p.in[13] + (size_t)l * 2048 * 1024, wt + E_WSSD, 2048, 1024, 1, t};
    t -= T_WSSD;
    if (t < T_WSC) return CvtTile{p.in[15] + (size_t)l * 1024 * 1024, wt + E_WSC, 1024, 1024, 1, t};
    t -= T_WSC;
    if (t < T_WO) return CvtTile{p.in[16] + (size_t)l * 1024 * 1024, wt + E_WO, 1024, 1024, 1, t};
    t -= T_WO;
    if (t < T_WUP) return CvtTile{p.in[19] + (size_t)l * 1024 * 5632, wt + E_WUP, 1024, 5632, 3, t};
    t -= T_WUP;
    return CvtTile{p.in[22] + (size_t)l * 2816 * 1024, wt + E_WDN, 2816, 1024, 1, t};
}
__device__ __forceinline__ void prep_phase(const Params& p, float* sm, int lsel, int bid, int nblk) {
    constexpr int T_LAYER = (NPI / 64) * 16 + 16 * 32 + 16 * 16 + 16 * 16 + 88 * 16 + 16 * 44;
    constexpr int N_MOD = 192, NB = 3;
    int tid_ = threadIdx.x; asm volatile("" : "+v"(tid_));
    if (lsel == 0) for (int it = bid; it < N_MOD; it += nblk) mod_item(p, it, sm);
    for (int t0 = bid; t0 < T_LAYER; t0 += NB * nblk) {
        CvtTile c[NB]; float v[NB][8];
#pragma unroll
        for (int q = 0; q < NB; ++q) { const int t = t0 + q * nblk; c[q] = prep_tile(p, lsel, t < T_LAYER ? t : t0); convert_load(c[q], v[q], tid_); }
#pragma unroll
        for (int q = 0; q < NB; ++q) convert_stash(v[q], sm + q * (64 * 65), tid_);
        __syncthreads();
#pragma unroll
        for (int q = 0; q < NB; ++q) { const int t = t0 + q * nblk; if (t < T_LAYER) convert_store(c[q], sm + q * (64 * 65), tid_); }
        __syncthreads();
    }
}

template <bool HAS_Y, bool HAS_H, bool XIB = false, bool XOB = false>
__device__ __forceinline__ void resnorm_phase(const float* xin, const bf16_t* __restrict__ y, float* xout, bf16_t* __restrict__ hout,
                                              const float* __restrict__ gt, const float* __restrict__ postg, const float* __restrict__ preg,
                                              const float* __restrict__ scv, const float* __restrict__ shv, int row0, int bid, int nblk) {
    int tid_ = threadIdx.x; asm volatile("" : "+v"(tid_));
    const int lane = tid_ & 63, wid = tid_ >> 6;
    const int nw = nblk * 8;
    constexpr bool ONEB = (MS <= SEQ);
    f32x4 pA[4], pB[4], pS[4];
    if (ONEB) { const int b0 = row0 >> 12;
#pragma unroll
        for (int i = 0; i < 4; ++i) { const int col = (i * 64 + lane) * 4;
            if (HAS_Y) pA[i] = *(const f32x4*)(gt + b0 * 6144 + col) * *(const f32x4*)(postg + col);
            if (HAS_H) { pB[i] = *(const f32x4*)(preg + col) * (*(const f32x4*)(scv + b0 * 6144 + col) + 1.0f); pS[i] = *(const f32x4*)(shv + b0 * 6144 + col); } } }
    for (int rb = bid * 8 + wid; rb < MS; rb += 2 * nw) {
        f32x4 xv[2][4]; u32x2 yv[2][4];
#pragma unroll
        for (int q = 0; q < 2; ++q) { const int r = rb + q * nw; if (r < MS) {
#pragma unroll
            for (int i = 0; i < 4; ++i) {
                if (XIB) { const u32x2 xb = __builtin_nontemporal_load((const u32x2*)((const bf16_t*)(xin + (size_t)(row0 + r) * 1024) + (i * 64 + lane) * 4)); xv[q][i][0] = bf_lo(xb.x); xv[q][i][1] = bf_hi(xb.x); xv[q][i][2] = bf_lo(xb.y); xv[q][i][3] = bf_hi(xb.y); }
                else xv[q][i] = __builtin_nontemporal_load((const f32x4*)(xin + (size_t)(row0 + r) * 1024 + (i * 64 + lane) * 4));
                if (HAS_Y) yv[q][i] = __builtin_nontemporal_load((const u32x2*)(y + (size_t)r * 1024 + (i * 64 + lane) * 4)); } } }
#pragma unroll
        for (int q = 0; q < 2; ++q) { const int r = rb + q * nw; if (r < MS) {
            const int tok = row0 + r, b = tok >> 12;
            if (HAS_Y) {
                f32x4 yf[4]; float ss = 0.f;
#pragma unroll
                for (int i = 0; i < 4; ++i) { yf[i][0] = bf_lo(yv[q][i].x); yf[i][1] = bf_hi(yv[q][i].x); yf[i][2] = bf_lo(yv[q][i].y); yf[i][3] = bf_hi(yv[q][i].y); ss += yf[i][0] * yf[i][0] + yf[i][1] * yf[i][1] + yf[i][2] * yf[i][2] + yf[i][3] * yf[i][3]; }
                ss = wave_sum(ss);
                const float rinv = rsqrtf(ss * (1.0f / 1024.0f) + EPS);
#pragma unroll
                for (int i = 0; i < 4; ++i) { const int col = (i * 64 + lane) * 4;
                    if (ONEB) xv[q][i] = xv[q][i] + pA[i] * (yf[i] * rinv);
                    else { const f32x4 g = *(const f32x4*)(gt + b * 6144 + col), pg = *(const f32x4*)(postg + col); xv[q][i] = xv[q][i] + g * (yf[i] * rinv * pg); }
                    if (XOB) { u32x2 xw; xw.x = pk_bf16(xv[q][i][0], xv[q][i][1]); xw.y = pk_bf16(xv[q][i][2], xv[q][i][3]); __builtin_nontemporal_store(xw, (u32x2*)((bf16_t*)(xout + (size_t)tok * 1024) + col)); }
                    else __builtin_nontemporal_store(xv[q][i], (f32x4*)(xout + (size_t)tok * 1024 + col)); }
            }
            if (HAS_H) {
                float ss = 0.f;
#pragma unroll
                for (int i = 0; i < 4; ++i) ss += xv[q][i][0] * xv[q][i][0] + xv[q][i][1] * xv[q][i][1] + xv[q][i][2] * xv[q][i][2] + xv[q][i][3] * xv[q][i][3];
                ss = wave_sum(ss);
                const float rinv = rsqrtf(ss * (1.0f / 1024.0f) + EPS);
#pragma unroll
                for (int i = 0; i < 4; ++i) { const int col = (i * 64 + lane) * 4; f32x4 hv;
                    if (ONEB) hv = (xv[q][i] * rinv) * pB[i] + pS[i];
                    else { const f32x4 pg = *(const f32x4*)(preg + col), sc = *(const f32x4*)(scv + b * 6144 + col), sh = *(const f32x4*)(shv + b * 6144 + col); hv = (xv[q][i] * rinv * pg) * (sc + 1.0f) + sh; }
                    u32x2 w; w.x = pk_bf16(hv[0], hv[1]); w.y = pk_bf16(hv[2], hv[3]);
                    *(u32x2*)(hout + (size_t)r * 1024 + col) = w; }
            }
        } }
    }
}

__device__ __forceinline__ void ssd_acs(const float* __restrict__ DT, const float* __restrict__ a_log, int r0, int g, float* sAcs, float* sDtv, float* cd_out) {
    int tid_ = threadIdx.x; asm volatile("" : "+v"(tid_));
    const int lane = tid_ & 63, hh = tid_ >> 6, h = g * 8 + hh;
    const float a = -__expf(a_log[h]);
    const int l0 = 2 * lane;
    const float d0 = DT[(size_t)(r0 + l0) * 32 + h], d1 = DT[(size_t)(r0 + l0 + 1) * 32 + h];
    const float v0 = a * d0, v1 = a * d1, s = v0 + v1;
    float incl = s;
#pragma unroll
    for (int o = 1; o < 64; o <<= 1) { const float t = __shfl_up(incl, o); if (lane >= o) incl += t; }
    const float excl = incl - s;
    sAcs[hh * 128 + l0] = excl + v0; sAcs[hh * 128 + l0 + 1] = incl;
    if (sDtv) { sDtv[hh * 128 + l0] = d0; sDtv[hh * 128 + l0 + 1] = d1; }
    if (cd_out && lane == 63) cd_out[hh] = __expf(incl);
}

template <int NC>
__device__ __forceinline__ void conv_rows8(const bf16_t* __restrict__ XBC, const float* __restrict__ cw, const float* __restrict__ cb, int r0, int l0, int col, bool first, float (&o)[8][NC]) {
    float raw[11][NC];
#pragma unroll
    for (int i = 0; i < 11; ++i) {
        const bool zero = first && (l0 + i - 3 < 0);
        if constexpr (NC == 8) { u32x4 v = (u32x4){0u, 0u, 0u, 0u}; if (!zero) v = *(const u32x4*)(XBC + (size_t)(r0 + l0 + i - 3) * 3072 + col);
            raw[i][0] = bf_lo(v.x); raw[i][1] = bf_hi(v.x); raw[i][2] = bf_lo(v.y); raw[i][3] = bf_hi(v.y); raw[i][4] = bf_lo(v.z); raw[i][5] = bf_hi(v.z); raw[i][6] = bf_lo(v.w); raw[i][7] = bf_hi(v.w); }
        else { unsigned v = 0u; if (!zero) v = *(const unsigned*)(XBC + (size_t)(r0 + l0 + i - 3) * 3072 + col); raw[i][0] = bf_lo(v); raw[i][1] = bf_hi(v); }
    }
#pragma unroll
    for (int j = 0; j < NC; ++j) { const float w0 = cw[col + j], w1 = cw[3072 + col + j], w2 = cw[2 * 3072 + col + j], w3 = cw[3 * 3072 + col + j], bb = cb[col + j];
#pragma unroll
        for (int i = 0; i < 8; ++i) o[i][j] = fsilu(bb + w0 * raw[i][j] + w1 * raw[i + 1][j] + w2 * raw[i + 2][j] + w3 * raw[i + 3][j]); }
}


__device__ __forceinline__ void conv2_load(const bf16_t* __restrict__ XBC, const float* __restrict__ cw, const float* __restrict__ cb, int r0, int l0, int col, bool first, unsigned (&rv)[11], f32x2 (&wv)[5]) {
#pragma unroll
    for (int i = 0; i < 11; ++i) { const bool zero = first && (l0 + i - 3 < 0); unsigned v = 0u; if (!zero) v = *(const unsigned*)(XBC + (size_t)(r0 + l0 + i - 3) * 3072 + col); rv[i] = v; }
#pragma unroll
    for (int k = 0; k < 4; ++k) wv[k] = *(const f32x2*)(cw + k * 3072 + col);
    wv[4] = *(const f32x2*)(cb + col);
}
__device__ __forceinline__ void conv2_compute(const unsigned (&rv)[11], const f32x2 (&wv)[5], float (&o)[8][2]) {
#pragma unroll
    for (int j = 0; j < 2; ++j) { const float w0 = wv[0][j], w1 = wv[1][j], w2 = wv[2][j], w3 = wv[3][j], bb = wv[4][j];
#pragma unroll
        for (int i = 0; i < 8; ++i) { const float r0_ = j ? bf_hi(rv[i]) : bf_lo(rv[i]), r1_ = j ? bf_hi(rv[i + 1]) : bf_lo(rv[i + 1]), r2_ = j ? bf_hi(rv[i + 2]) : bf_lo(rv[i + 2]), r3_ = j ? bf_hi(rv[i + 3]) : bf_lo(rv[i + 3]);
            o[i][j] = fsilu(bb + w0 * r0_ + w1 * r1_ + w2 * r2_ + w3 * r3_); } }
}

constexpr int LS = 136;

__device__ __forceinline__ void ssdA_phase(const Params& p, unsigned char* gws, int bid, int nblk, int l, unsigned char* smem) {
    int tid_ = threadIdx.x; asm volatile("" : "+v"(tid_));
    const int tid = tid_, lane = tid & 63, w = tid >> 6, fr = lane & 15, fq = lane >> 4;
    bf16_t* sC = (bf16_t*)smem; bf16_t* sB = sC + 128 * LS; bf16_t* sBt = sB + 128 * LS;
    float* sAcs = (float*)(smem + 3 * 128 * LS * 2); float* sDtv = sAcs + 8 * 128;
    const bf16_t* XBC = (const bf16_t*)(gws + OFF_XBC); const float* DT = (const float*)(gws + OFF_DT);
    bf16_t* YP = (bf16_t*)(gws + OFF_YP); bf16_t* ST = (bf16_t*)(gws + OFF_ST); float* CD = (float*)(gws + OFF_CD);
    const float* cw = p.in[7] + (size_t)l * 4 * 3072; const float* cb = p.in[8] + l * 3072;
    const float* a_log = p.in[10] + l * 32; const float* dsk = p.in[11] + l * 32;
    for (int item = bid; item < SB * 32 * 4; item += nblk) {
        const int bl = item >> 7, c = (item >> 2) & 31, g = item & 3; const int r0 = bl * 4096 + c * 128; const bool first = (c == 0);
        ssd_acs(DT, a_log, r0, g, sAcs, sDtv, CD + (bl * 32 + c) * 32 + g * 8);
        {
            const int cg8 = tid & 31, l0 = (tid >> 5) * 8, isC = cg8 >> 4, n0 = (cg8 & 15) * 8; const int col = 2048 + isC * 512 + g * 128 + n0;
            float o[8][8]; conv_rows8<8>(XBC, cw, cb, r0, l0, col, first, o);
            bf16_t* dst = isC ? sC : sB;
#pragma unroll
            for (int i = 0; i < 8; ++i) { u32x4 v; v.x = pk_bf16(o[i][0], o[i][1]); v.y = pk_bf16(o[i][2], o[i][3]); v.z = pk_bf16(o[i][4], o[i][5]); v.w = pk_bf16(o[i][6], o[i][7]);
                *(u32x4*)(dst + (l0 + i) * LS + n0) = v; }
            if (!isC) {
#pragma unroll
                for (int j = 0; j < 8; ++j) { u32x4 v; v.x = pk_bf16(o[0][j], o[1][j]); v.y = pk_bf16(o[2][j], o[3][j]); v.z = pk_bf16(o[4][j], o[5][j]); v.w = pk_bf16(o[6][j], o[7][j]);
                    *(u32x4*)(sBt + (n0 + j) * LS + l0) = v; }
            }
        }
        __syncthreads();
        f32x4 sacc[8];
#pragma unroll
        for (int st = 0; st < 8; ++st) sacc[st] = (f32x4){0.f, 0.f, 0.f, 0.f};
#pragma unroll
        for (int kk = 0; kk < 4; ++kk) { const bf16x8 a = *(const bf16x8*)(sC + (16 * w + fr) * LS + 32 * kk + 8 * fq);
#pragma unroll
            for (int st = 0; st < 8; ++st) { const bf16x8 b = *(const bf16x8*)(sB + (16 * st + fr) * LS + 32 * kk + 8 * fq);
                sacc[st] = __builtin_amdgcn_mfma_f32_16x16x32_bf16(b, a, sacc[st], 0, 0, 0); } }
        __syncthreads();
        unsigned rvn[11]; f32x2 wvn[5];
        const int p0 = (tid & 31) * 2, lx0 = (tid >> 5) * 8, colx = g * 512 + p0;
        conv2_load(XBC, cw, cb, r0, lx0, colx, first, rvn, wvn);
#define SSDA_CONVX(hx, XT_, XDT_) do { \
            unsigned rvc[11]; f32x2 wvc[5]; \
            _Pragma("unroll") for (int i = 0; i < 11; ++i) rvc[i] = rvn[i]; \
            _Pragma("unroll") for (int i = 0; i < 5; ++i) wvc[i] = wvn[i]; \
            if ((hx) < 7) conv2_load(XBC, cw, cb, r0, lx0, colx + ((hx) + 1) * 64, first, rvn, wvn); \
            float o[8][2]; conv2_compute(rvc, wvc, o); \
            const float alast = sAcs[(hx) * 128 + 127]; \
            float xd[8][2], xe[8][2]; \
            _Pragma("unroll") for (int i = 0; i < 8; ++i) { const float dtl = sDtv[(hx) * 128 + lx0 + i], de = __expf(alast - sAcs[(hx) * 128 + lx0 + i]); \
                xd[i][0] = o[i][0] * dtl; xd[i][1] = o[i][1] * dtl; xe[i][0] = xd[i][0] * de; xe[i][1] = xd[i][1] * de; } \
            _Pragma("unroll") for (int j = 0; j < 2; ++j) { u32x4 v; v.x = pk_bf16(xd[0][j], xd[1][j]); v.y = pk_bf16(xd[2][j], xd[3][j]); v.z = pk_bf16(xd[4][j], xd[5][j]); v.w = pk_bf16(xd[6][j], xd[7][j]); \
                *(u32x4*)((XT_) + (p0 + j) * LS + lx0) = v; \
                u32x4 e; e.x = pk_bf16(xe[0][j], xe[1][j]); e.y = pk_bf16(xe[2][j], xe[3][j]); e.z = pk_bf16(xe[4][j], xe[5][j]); e.w = pk_bf16(xe[6][j], xe[7][j]); \
                *(u32x4*)((XDT_) + (p0 + j) * LS + lx0) = e; } } while (0)
        bf16_t* sX = sC;
        SSDA_CONVX(0, sX, sX + 64 * LS);
        __syncthreads();
#pragma unroll 1
        for (int hh = 0; hh < 8; ++hh) {
            const int h = g * 8 + hh;
            const bf16_t* Xt_c = sX + (hh & 1) * (128 * LS); const bf16_t* Xdt_c = Xt_c + 64 * LS;
            if (hh < 7) { bf16_t* Xt_n = sX + ((hh + 1) & 1) * (128 * LS); SSDA_CONVX(hh + 1, Xt_n, Xt_n + 64 * LS); }
            {
                const int lrow = 16 * w + fr; const float acs_l = sAcs[hh * 128 + lrow]; const float dsk_dt = dsk[h] / fmaxf(sDtv[hh * 128 + lrow], 1e-30f);
                f32x4 yacc[4];
#pragma unroll
                for (int pt = 0; pt < 4; ++pt) yacc[pt] = (f32x4){0.f, 0.f, 0.f, 0.f};
                const int kkmax = w >> 1;
#pragma unroll
                for (int kk = 0; kk < 4; ++kk) { if (kk <= kkmax) {
                        const f32x4 as0 = *(const f32x4*)(sAcs + hh * 128 + 32 * kk + 4 * fq), as1 = *(const f32x4*)(sAcs + hh * 128 + 32 * kk + 16 + 4 * fq);
                        float mv[8];
#pragma unroll
                        for (int e = 0; e < 4; ++e) { const int s0 = 32 * kk + 4 * fq + e, s1 = s0 + 16;
                            float m0 = (s0 <= lrow) ? sacc[2 * kk][e] * __expf(fminf(acs_l - as0[e], 0.f)) : 0.f; if (s0 == lrow) m0 += dsk_dt;
                            float m1 = (s1 <= lrow) ? sacc[2 * kk + 1][e] * __expf(fminf(acs_l - as1[e], 0.f)) : 0.f; if (s1 == lrow) m1 += dsk_dt;
                            mv[e] = m0; mv[4 + e] = m1; }
                        u32x4 mk; mk.x = pk_bf16(mv[0], mv[1]); mk.y = pk_bf16(mv[2], mv[3]); mk.z = pk_bf16(mv[4], mv[5]); mk.w = pk_bf16(mv[6], mv[7]);
                        const bf16x8 a = __builtin_bit_cast(bf16x8, mk);
#pragma unroll
                        for (int pt = 0; pt < 4; ++pt) { const u32x2 lo = *(const u32x2*)(Xt_c + (16 * pt + fr) * LS + 32 * kk + 4 * fq), hi = *(const u32x2*)(Xt_c + (16 * pt + fr) * LS + 32 * kk + 16 + 4 * fq);
                            u32x4 bk; bk.x = lo.x; bk.y = lo.y; bk.z = hi.x; bk.w = hi.y;
                            yacc[pt] = __builtin_amdgcn_mfma_f32_16x16x32_bf16(__builtin_bit_cast(bf16x8, bk), a, yacc[pt], 0, 0, 0); } } }
                bf16_t* yrow = YP + (size_t)(r0 + 16 * w + fr) * 2048 + g * 512 + hh * 64 + 4 * fq;
#pragma unroll
                for (int pt = 0; pt < 4; ++pt) { u32x2 pk; pk.x = pk_bf16(yacc[pt][0], yacc[pt][1]); pk.y = pk_bf16(yacc[pt][2], yacc[pt][3]); *(u32x2*)(yrow + 16 * pt) = pk; }
            }
            {
                f32x4 zacc[4];
#pragma unroll
                for (int pt = 0; pt < 4; ++pt) zacc[pt] = (f32x4){0.f, 0.f, 0.f, 0.f};
#pragma unroll
                for (int kk = 0; kk < 4; ++kk) { const bf16x8 bfr = *(const bf16x8*)(sBt + (16 * w + fr) * LS + 32 * kk + 8 * fq);
#pragma unroll
                    for (int pt = 0; pt < 4; ++pt) { const bf16x8 xa = *(const bf16x8*)(Xdt_c + (16 * pt + fr) * LS + 32 * kk + 8 * fq);
                        zacc[pt] = __builtin_amdgcn_mfma_f32_16x16x32_bf16(bfr, xa, zacc[pt], 0, 0, 0); } }
                bf16_t* sp = ST + ((size_t)((bl * 32 + c) * 32 + h)) * 8192 + fr * 128 + 16 * w + 4 * fq;
#pragma unroll
                for (int pt = 0; pt < 4; ++pt) { u32x2 pk; pk.x = pk_bf16(zacc[pt][0], zacc[pt][1]); pk.y = pk_bf16(zacc[pt][2], zacc[pt][3]); *(u32x2*)(sp + (16 * pt) * 128) = pk; }
            }
            __syncthreads();
        }
#undef SSDA_CONVX
    }
}

__device__ __forceinline__ void ssdB_phase(const Params& p, unsigned char* gws, int bid, int nblk, int l) {
    int tid_ = threadIdx.x; asm volatile("" : "+v"(tid_));
    const int gtid = bid * 512 + tid_, nthr = nblk * 512;
    bf16_t* ST = (bf16_t*)(gws + OFF_ST); const float* CD = (const float*)(gws + OFF_CD);
    for (int idx = gtid; idx < SB * 32 * 64 * 16; idx += nthr) {
        const int n8 = idx & 15, pp = (idx >> 4) & 63, h = (idx >> 10) & 31, bl = idx >> 15;
        bf16_t* base = ST + ((size_t)(bl * 32 * 32 + h)) * 8192 + pp * 128 + n8 * 8;
        float hr[8];
#pragma unroll
        for (int j = 0; j < 8; ++j) hr[j] = 0.f;
#pragma unroll 1
        for (int c0 = 0; c0 < 32; c0 += 8) {
            u32x4 sv[8];
#pragma unroll
            for (int cc = 0; cc < 8; ++cc) sv[cc] = __builtin_nontemporal_load((const u32x4*)(base + (size_t)(c0 + cc) * 32 * 8192));
#pragma unroll
            for (int cc = 0; cc < 8; ++cc) { const float d = CD[(bl * 32 + c0 + cc) * 32 + h];
                u32x4 o; o.x = pk_bf16(hr[0], hr[1]); o.y = pk_bf16(hr[2], hr[3]); o.z = pk_bf16(hr[4], hr[5]); o.w = pk_bf16(hr[6], hr[7]);
                *(u32x4*)(base + (size_t)(c0 + cc) * 32 * 8192) = o;
                hr[0] = hr[0] * d + bf_lo(sv[cc].x); hr[1] = hr[1] * d + bf_hi(sv[cc].x); hr[2] = hr[2] * d + bf_lo(sv[cc].y); hr[3] = hr[3] * d + bf_hi(sv[cc].y);
                hr[4] = hr[4] * d + bf_lo(sv[cc].z); hr[5] = hr[5] * d + bf_hi(sv[cc].z); hr[6] = hr[6] * d + bf_lo(sv[cc].w); hr[7] = hr[7] * d + bf_hi(sv[cc].w); }
        }
    }
    const bf16_t* CHB = (const bf16_t*)(gws + OFF_CHB); bf16_t* SCB = (bf16_t*)(gws + OFF_SCB);
    const float* scw = p.in[14] + (size_t)l * 3 * 1024;
    for (int idx = gtid; idx < (MS / 16) * 128; idx += nthr) {
        const int cgp = idx & 127, run = idx >> 7; const int r = run * 16, ch = cgp * 8; const bool first = (r & 4095) == 0;
        float w0[8], w1[8], w2[8];
#pragma unroll
        for (int j = 0; j < 8; ++j) { w0[j] = scw[ch + j]; w1[j] = scw[1024 + ch + j]; w2[j] = scw[2048 + ch + j]; }
        u32x4 p2 = (u32x4){0u, 0u, 0u, 0u}, p1 = p2;
        if (!first) { p2 = *(const u32x4*)(CHB + (size_t)(r - 2) * 1024 + ch); p1 = *(const u32x4*)(CHB + (size_t)(r - 1) * 1024 + ch); }
#pragma unroll 1
        for (int i0 = 0; i0 < 16; i0 += 8) {
            u32x4 cv[8], bv[8];
#pragma unroll
            for (int i = 0; i < 8; ++i) { cv[i] = __builtin_nontemporal_load((const u32x4*)(CHB + (size_t)(r + i0 + i) * 1024 + ch)); bv[i] = __builtin_nontemporal_load((const u32x4*)(SCB + (size_t)(r + i0 + i) * 1024 + ch)); }
#pragma unroll
            for (int i = 0; i < 8; ++i) { float o[8];
#define SC1(j, P2, P1, CU, BB, LOHI) o[j] = LOHI(BB) * (w0[j] * LOHI(P2) + w1[j] * LOHI(P1) + w2[j] * LOHI(CU));
                SC1(0, p2.x, p1.x, cv[i].x, bv[i].x, bf_lo) SC1(1, p2.x, p1.x, cv[i].x, bv[i].x, bf_hi) SC1(2, p2.y, p1.y, cv[i].y, bv[i].y, bf_lo) SC1(3, p2.y, p1.y, cv[i].y, bv[i].y, bf_hi)
                SC1(4, p2.z, p1.z, cv[i].z, bv[i].z, bf_lo) SC1(5, p2.z, p1.z, cv[i].z, bv[i].z, bf_hi) SC1(6, p2.w, p1.w, cv[i].w, bv[i].w, bf_lo) SC1(7, p2.w, p1.w, cv[i].w, bv[i].w, bf_hi)
#undef SC1
                u32x4 ov; ov.x = pk_bf16(o[0], o[1]); ov.y = pk_bf16(o[2], o[3]); ov.z = pk_bf16(o[4], o[5]); ov.w = pk_bf16(o[6], o[7]);
                *(u32x4*)(SCB + (size_t)(r + i0 + i) * 1024 + ch) = ov;
                p2 = p1; p1 = cv[i]; }
        }
    }
}

__device__ __forceinline__ void ssdC_phase(const Params& p, unsigned char* gws, int bid, int nblk, int l, unsigned char* smem) {
    int tid_ = threadIdx.x; asm volatile("" : "+v"(tid_));
    const int tid = tid_, lane = tid & 63, w = tid >> 6, fr = lane & 15, fq = lane >> 4;
    bf16_t* sC = (bf16_t*)smem; bf16_t* sPrev = sC + 128 * LS; float* sAcs = (float*)(smem + (128 + 64) * LS * 2);
    const bf16_t* XBC = (const bf16_t*)(gws + OFF_XBC); const float* DT = (const float*)(gws + OFF_DT);
    const bf16_t* YP = (const bf16_t*)(gws + OFF_YP); const bf16_t* ST = (const bf16_t*)(gws + OFF_ST); const bf16_t* Z = (const bf16_t*)(gws + OFF_Z);
    bf16_t* SSDN = (bf16_t*)(gws + OFF_SSDN);
    const float* cw = p.in[7] + (size_t)l * 4 * 3072; const float* cb = p.in[8] + l * 3072;
    const float* a_log = p.in[10] + l * 32; const float* ng = p.in[12] + l * 2048;
    for (int item = bid; item < SB * 32 * 4; item += nblk) {
        const int bl = item >> 7, c = (item >> 2) & 31, g = item & 3; const int r0 = bl * 4096 + c * 128; const bool first = (c == 0);
        ssd_acs(DT, a_log, r0, g, sAcs, nullptr, nullptr);
        if (tid < 256) {
            const int l0 = (tid >> 4) * 8, n0 = (tid & 15) * 8; const int col = 2048 + 512 + g * 128 + n0;
            float o[8][8]; conv_rows8<8>(XBC, cw, cb, r0, l0, col, first, o);
#pragma unroll
            for (int i = 0; i < 8; ++i) { u32x4 v; v.x = pk_bf16(o[i][0], o[i][1]); v.y = pk_bf16(o[i][2], o[i][3]); v.z = pk_bf16(o[i][4], o[i][5]); v.w = pk_bf16(o[i][6], o[i][7]);
                *(u32x4*)(sC + (l0 + i) * LS + n0) = v; }
        }
        __syncthreads();
        bf16x8 ca[4];
#pragma unroll
        for (int kk = 0; kk < 4; ++kk) ca[kk] = *(const bf16x8*)(sC + (16 * w + fr) * LS + 32 * kk + 8 * fq);
        const int lrow = 16 * w + fr;
        u32x2 y[8][4]; float ss = 0.f;
        const int prow_ = tid >> 3, pseg_ = (tid & 7) * 16; const bf16_t* psrc = ST + ((size_t)((bl * 32 + c) * 32 + g * 8)) * 8192 + prow_ * 128 + pseg_;
        u32x4 nv0 = *(const u32x4*)psrc, nv1 = *(const u32x4*)(psrc + 8);
#pragma unroll
        for (int hh = 0; hh < 8; ++hh) {
            const size_t off = (size_t)(r0 + lrow) * 2048 + g * 512 + hh * 64 + 4 * fq;
            u32x2 ypq[4], zzq[4];
            {
                const u32x4 v0 = nv0, v1 = nv1;
                if (hh < 7) { nv0 = *(const u32x4*)(psrc + (size_t)(hh + 1) * 8192); nv1 = *(const u32x4*)(psrc + (size_t)(hh + 1) * 8192 + 8); }
#pragma unroll
                for (int pt = 0; pt < 4; ++pt) { ypq[pt] = *(const u32x2*)(YP + off + 16 * pt); zzq[pt] = *(const u32x2*)(Z + off + 16 * pt); }
                __syncthreads();
                *(u32x4*)(sPrev + prow_ * LS + pseg_) = v0; *(u32x4*)(sPrev + prow_ * LS + pseg_ + 8) = v1;
                __syncthreads();
            }
            f32x4 acc[4];
#pragma unroll
            for (int pt = 0; pt < 4; ++pt) acc[pt] = (f32x4){0.f, 0.f, 0.f, 0.f};
#pragma unroll
            for (int kk = 0; kk < 4; ++kk)
#pragma unroll
                for (int pt = 0; pt < 4; ++pt) { const bf16x8 b = *(const bf16x8*)(sPrev + (16 * pt + fr) * LS + 32 * kk + 8 * fq);
                    acc[pt] = __builtin_amdgcn_mfma_f32_16x16x32_bf16(b, ca[kk], acc[pt], 0, 0, 0); }
            const float el = __expf(sAcs[hh * 128 + lrow]);
#pragma unroll
            for (int pt = 0; pt < 4; ++pt) { const u32x2 yp = ypq[pt], zz = zzq[pt];
                f32x4 v; v[0] = (el * acc[pt][0] + bf_lo(yp.x)) * bf_lo(zz.x); v[1] = (el * acc[pt][1] + bf_hi(yp.x)) * bf_hi(zz.x);
                v[2] = (el * acc[pt][2] + bf_lo(yp.y)) * bf_lo(zz.y); v[3] = (el * acc[pt][3] + bf_hi(yp.y)) * bf_hi(zz.y);
                u32x2 yk; yk.x = pk_bf16(v[0], v[1]); yk.y = pk_bf16(v[2], v[3]); y[hh][pt] = yk; ss += v[0] * v[0] + v[1] * v[1] + v[2] * v[2] + v[3] * v[3]; }
        }
        ss += __shfl_xor(ss, 16); ss += __shfl_xor(ss, 32);
        const float rinv = rsqrtf(ss * (1.0f / 512.0f) + EPS);
#pragma unroll
        for (int hh = 0; hh < 8; ++hh)
#pragma unroll
            for (int pt = 0; pt < 4; ++pt) { const int colg = g * 512 + hh * 64 + 16 * pt + 4 * fq; const f32x4 gg = *(const f32x4*)(ng + colg); const u32x2 yk = y[hh][pt]; f32x4 v; v[0] = bf_lo(yk.x) * rinv * gg[0]; v[1] = bf_hi(yk.x) * rinv * gg[1]; v[2] = bf_lo(yk.y) * rinv * gg[2]; v[3] = bf_hi(yk.y) * rinv * gg[3];
                u32x2 pk; pk.x = pk_bf16(v[0], v[1]); pk.y = pk_bf16(v[2], v[3]);
                *(u32x2*)(SSDN + (size_t)(r0 + lrow) * 2048 + colg) = pk; }
        __syncthreads();
    }
}

__device__ __forceinline__ void ffnact_phase(const Params& p, unsigned char* gws, int bid, int nblk, int l) {
    int tid_ = threadIdx.x; asm volatile("" : "+v"(tid_));
    const int gtid = bid * 512 + tid_, nthr = nblk * 512;
    const bf16_t* U = (const bf16_t*)(gws + OFF_U); bf16_t* ACT = (bf16_t*)(gws + OFF_ACT);
    const float* fw = p.in[20] + (size_t)l * 3 * 5632; const float* fb = p.in[21] + (size_t)l * 5632;
    constexpr int RUN = 90, NRUN = (MS + RUN - 1) / RUN;
    for (int idx = gtid; idx < NRUN * 352; idx += nthr) {
        const int run = idx / 352, cgp = idx - run * 352; const int r = run * RUN, ch = cgp * 8; const int rend = (r + RUN < MS) ? r + RUN : MS;
        float wg0[8], wg1[8], wg2[8], bg[8], wv0[8], wv1[8], wv2[8], bv[8];
#pragma unroll
        for (int j = 0; j < 8; ++j) { wg0[j] = fw[ch + j]; wg1[j] = fw[5632 + ch + j]; wg2[j] = fw[2 * 5632 + ch + j]; bg[j] = fb[ch + j];
            wv0[j] = fw[2816 + ch + j]; wv1[j] = fw[5632 + 2816 + ch + j]; wv2[j] = fw[2 * 5632 + 2816 + ch + j]; bv[j] = fb[2816 + ch + j]; }
        u32x4 g2 = (u32x4){0u, 0u, 0u, 0u}, g1 = g2, v2 = g2, v1 = g2;
        if ((r & 4095) >= 2) { g2 = *(const u32x4*)(U + (size_t)(r - 2) * 5632 + ch); v2 = *(const u32x4*)(U + (size_t)(r - 2) * 5632 + 2816 + ch); }
        if ((r & 4095) >= 1) { g1 = *(const u32x4*)(U + (size_t)(r - 1) * 5632 + ch); v1 = *(const u32x4*)(U + (size_t)(r - 1) * 5632 + 2816 + ch); }
#pragma unroll 1
        for (int t0 = r; t0 < rend; t0 += 6) {
            u32x4 gv[6], vv[6];
#pragma unroll
            for (int i = 0; i < 6; ++i) { const int t = (t0 + i < rend) ? t0 + i : rend - 1; gv[i] = *(const u32x4*)(U + (size_t)t * 5632 + ch); vv[i] = *(const u32x4*)(U + (size_t)t * 5632 + 2816 + ch); }
#pragma unroll
            for (int i = 0; i < 6; ++i) { const int t = t0 + i; if (t < rend) {
                if ((t & 4095) == 0) { g2 = (u32x4){0u, 0u, 0u, 0u}; g1 = g2; v2 = g2; v1 = g2; } else if ((t & 4095) == 1) { g2 = (u32x4){0u, 0u, 0u, 0u}; v2 = g2; }
                float o[8];
#define FF1(j, A2, A1, AC, B2, B1, BC, LOHI) { const float ug = bg[j] + wg0[j] * LOHI(A2) + wg1[j] * LOHI(A1) + wg2[j] * LOHI(AC); const float uv = bv[j] + wv0[j] * LOHI(B2) + wv1[j] * LOHI(B1) + wv2[j] * LOHI(BC); o[j] = fsilu(ug) * uv; }
                FF1(0, g2.x, g1.x, gv[i].x, v2.x, v1.x, vv[i].x, bf_lo) FF1(1, g2.x, g1.x, gv[i].x, v2.x, v1.x, vv[i].x, bf_hi)
                FF1(2, g2.y, g1.y, gv[i].y, v2.y, v1.y, vv[i].y, bf_lo) FF1(3, g2.y, g1.y, gv[i].y, v2.y, v1.y, vv[i].y, bf_hi)
                FF1(4, g2.z, g1.z, gv[i].z, v2.z, v1.z, vv[i].z, bf_lo) FF1(5, g2.z, g1.z, gv[i].z, v2.z, v1.z, vv[i].z, bf_hi)
                FF1(6, g2.w, g1.w, gv[i].w, v2.w, v1.w, vv[i].w, bf_lo) FF1(7, g2.w, g1.w, gv[i].w, v2.w, v1.w, vv[i].w, bf_hi)
#undef FF1
                u32x4 ov; ov.x = pk_bf16(o[0], o[1]); ov.y = pk_bf16(o[2], o[3]); ov.z = pk_bf16(o[4], o[5]); ov.w = pk_bf16(o[6], o[7]);
                *(u32x4*)(ACT + (size_t)t * 2816 + ch) = ov;
                g2 = g1; g1 = gv[i]; v2 = v1; v1 = vv[i]; } }
        }
    }
}

#define XB_TMO      128
#define XB_XCNT(j)  (256  + 64 * (j))
#define XB_XSUB(j)  (1280 + 64 * (j))
#define XB_XGEN(j)  (2304 + 64 * (j))
#define XB_TOP      3328
#define XB_TOPGEN   3392
#define XCD_BAR_WORDS 3456
#define XB_SPIN_CAP (1u << 22)
__device__ __forceinline__ unsigned xb_ld(unsigned* p)              { return __hip_atomic_load(p, __ATOMIC_RELAXED, __HIP_MEMORY_SCOPE_AGENT); }
__device__ __forceinline__ unsigned xb_add(unsigned* p, unsigned v) { return __hip_atomic_fetch_add(p, v, __ATOMIC_RELAXED, __HIP_MEMORY_SCOPE_AGENT); }
__device__ __forceinline__ unsigned xb_xcc_id() { return (unsigned)__builtin_amdgcn_s_getreg((3 << 11) | 20) & 0xFu; }
#define XB_SPIN(cond, bar) do { unsigned _sp = 0; while (cond) { __builtin_amdgcn_s_sleep(1); \
    if ((++_sp & 255u) == 0u) { if (xb_ld(&(bar)[XB_TMO])) break; if (_sp > XB_SPIN_CAP) { atomicAdd(&(bar)[XB_TMO], 1u); break; } } } } while (0)
struct XcdBarrier { unsigned* bar; unsigned x; unsigned G; volatile LAS unsigned* st; };
__device__ __forceinline__ XcdBarrier xcd_barrier_post(unsigned* bar, volatile LAS unsigned* st, unsigned G) {
    XcdBarrier b; b.bar = bar; b.x = xb_xcc_id(); b.st = st; b.G = G;
    if (threadIdx.x == 0) (void)xb_add(&bar[XB_XCNT(b.x)], 1u);
    return b;
}
__device__ __forceinline__ void xcd_barrier_complete(unsigned* bar, unsigned x, unsigned G, unsigned& nloc, unsigned& nx) {
    unsigned sum, cnt, mine, sp = 0u;
    for (;;) {
        sum = 0u; cnt = 0u; mine = 0u;
#pragma unroll
        for (unsigned j = 0; j < 16; ++j) { const unsigned c = xb_ld(&bar[XB_XCNT(j)]); sum += c; cnt += (c > 0u) ? 1u : 0u; mine = (j == x) ? c : mine; }
        if (sum == G) break;
        __builtin_amdgcn_s_sleep(1);
        if ((++sp & 255u) == 0u) { if (xb_ld(&bar[XB_TMO])) break; if (sp > XB_SPIN_CAP) { atomicAdd(&bar[XB_TMO], 1u); break; } }
    }
    nloc = mine > 0u ? mine : 1u; nx = cnt > 0u ? cnt : 1u;
}
__device__ __forceinline__ void xcd_barrier(const XcdBarrier& b) {
    asm volatile("s_waitcnt vmcnt(0)" ::: "memory");
    __syncthreads();
    if (threadIdx.x == 0) {
        unsigned* bar = b.bar;
        __builtin_amdgcn_s_waitcnt(0);
        unsigned nloc = b.st[0], nx = b.st[1];
        if (nloc == 0u) { xcd_barrier_complete(bar, b.x, b.G, nloc, nx); b.st[0] = nloc; b.st[1] = nx; }
        const unsigned old = xb_add(&bar[XB_XSUB(b.x)], 1u);
        const unsigned gen = old / nloc;
        if (old + 1u == (gen + 1u) * nloc) {
            if (nx > 1u) {
                __builtin_amdgcn_fence(__ATOMIC_RELEASE, "agent");
                asm volatile("s_waitcnt vmcnt(0)" ::: "memory");
                const unsigned og = xb_add(&bar[XB_TOP], 1u);
                const unsigned tg = og / nx;
                if (og + 1u == (tg + 1u) * nx) xb_add(&bar[XB_TOPGEN], 1u);
                else XB_SPIN(xb_ld(&bar[XB_TOPGEN]) == tg, bar);
            }
            __builtin_amdgcn_fence(__ATOMIC_ACQUIRE, "agent");
            xb_add(&bar[XB_XGEN(b.x)], 1u);
            asm volatile("s_waitcnt vmcnt(0)" ::: "memory");
        } else {
            XB_SPIN(xb_ld(&bar[XB_XGEN(b.x)]) == gen, bar);
            __builtin_amdgcn_fence(__ATOMIC_ACQUIRE, "agent");
            asm volatile("s_waitcnt vmcnt(0)" ::: "memory");
        }
    }
    __syncthreads();
}

__device__ __forceinline__ void dt_phase(const bf16_t* __restrict__ Hh, const bf16_t* __restrict__ Wd, const float* __restrict__ dt_bias, float* __restrict__ DT, int bid, int nblk) {
    int tid_ = threadIdx.x; asm volatile("" : "+v"(tid_));
    const int lane = tid_ & 63, w = tid_ >> 6, fr = lane & 15, fq = lane >> 4;
    for (int u = bid; u < MS / 128; u += nblk) {
        const int row = u * 128 + 16 * w + fr;
        const bf16_t* ap = Hh + (size_t)row * 1024 + 8 * fq; const bf16_t* bp0 = Wd + (size_t)fr * 1024 + 8 * fq; const bf16_t* bp1 = bp0 + 16 * 1024;
        f32x4 acc0 = (f32x4){0.f, 0.f, 0.f, 0.f}, acc1 = acc0;
#pragma unroll 1
        for (int k0 = 0; k0 < 32; k0 += 8) {
            bf16x8 a[8], b0[8], b1[8];
#pragma unroll
            for (int k = 0; k < 8; ++k) { a[k] = *(const bf16x8*)(ap + 32 * (k0 + k)); b0[k] = *(const bf16x8*)(bp0 + 32 * (k0 + k)); b1[k] = *(const bf16x8*)(bp1 + 32 * (k0 + k)); }
#pragma unroll
            for (int k = 0; k < 8; ++k) { acc0 = __builtin_amdgcn_mfma_f32_16x16x32_bf16(b0[k], a[k], acc0, 0, 0, 0); acc1 = __builtin_amdgcn_mfma_f32_16x16x32_bf16(b1[k], a[k], acc1, 0, 0, 0); }
        }
        const int h0 = 8 * fq; f32x4 o0, o1;
#pragma unroll
        for (int e = 0; e < 4; ++e) { const float x0 = acc0[e] + dt_bias[h0 + e], x1 = acc1[e] + dt_bias[h0 + 4 + e];
            o0[e] = x0 > 20.f ? x0 : log1pf(expf(x0)); o1[e] = x1 > 20.f ? x1 : log1pf(expf(x1)); }
        *(f32x4*)(DT + (size_t)row * 32 + h0) = o0; *(f32x4*)(DT + (size_t)row * 32 + h0 + 4) = o1;
    }
}

__global__ void __launch_bounds__(512) fwd_megakernel(Params p) {
    extern __shared__ __attribute__((aligned(16))) unsigned char smem[];
    cg::grid_group grid = cg::this_grid();
    LAS unsigned char* lds = (LAS unsigned char*)smem;
    const int bx = blockIdx.x;
    const int grp = (bx & 7) / XPG;
    const int bid = (bx >> 3) * XPG + (bx & 7) % XPG;
    const int nblk = GBLK;
    unsigned char* ws = p.ws;
    unsigned char* gws = ws + OFF_GRP + (size_t)grp * GSTRIDE;
    volatile LAS unsigned* xst = (volatile LAS unsigned*)(lds + 131072);
    if (threadIdx.x == 0) { xst[0] = 0u; xst[1] = 0u; }
    __syncthreads();
    static_assert(NGRP * 16384 <= BAR_BYTES, "barrier words");
    if (bx < NGRP) { unsigned* bw = (unsigned*)(ws + OFF_BAR + (size_t)bx * 16384); for (int i = threadIdx.x; i < 4096; i += 512) bw[i] = 0u; }
    const float* modb = (const float*)(ws + OFF_MOD);
    bf16_t* H = (bf16_t*)(gws + OFF_H);
    pg8::StaticOrder S;

    prep_phase(p, (float*)smem, 0, bx, (int)gridDim.x);
    prep_phase(p, (float*)smem, 1, bx, (int)gridDim.x);
    grid.sync();
    XcdBarrier xb = xcd_barrier_post((unsigned*)(ws + OFF_BAR + (size_t)grp * 16384), xst, (unsigned)nblk);
#define BAR_() xcd_barrier(xb)
#pragma unroll 1
    for (int si = 0; si < NSL / NGRP; ++si) {
#pragma unroll 1
        for (int l = 0; l < DEPTH; ++l) {
            int sl = grp + NGRP * si;
            asm volatile("" : "+s"(l), "+s"(sl));
#define mod (modb + (size_t)l * 16 * 6144)
#define mod1 (modb + (size_t)16 * 6144)
#define wt ((const bf16_t*)(ws + OFF_WT) + (size_t)l * E_WLAYER)
#define row0 (sl * MS)
#define LAUNDER() asm volatile("" : "+s"(l), "+s"(sl))
            if (l == 0 && si == 0) {
                resnorm_phase<false, true>(p.in[0], nullptr, nullptr, H, nullptr, nullptr, p.in[4], mod + 1024, mod, row0, bid, nblk);
                BAR_(); LAUNDER();
            }
            { pg8::Gemm g{H, wt + E_WIN, MS, NPI - 256, 1024}; S.init(MS, NPI - 256, nblk, bid);
              EpiInProj E{(bf16_t*)(gws + OFF_Z), (bf16_t*)(gws + OFF_XBC), (bf16_t*)(gws + OFF_SCB), (bf16_t*)(gws + OFF_CHB), (bf16_t*)(gws + OFF_G), (float*)(gws + OFF_DT), p.in[9] + l * 32};
              pg8::gemm_phase(lds, g, S, E); }
            dt_phase(H, wt + E_WIN + (size_t)(NPI - 256) * 1024, p.in[9] + l * 32, (float*)(gws + OFF_DT), bid, nblk);
            BAR_(); LAUNDER();
            ssdA_phase(p, gws, bid, nblk, l, smem);
            BAR_(); LAUNDER();
            ssdB_phase(p, gws, bid, nblk, l);
            BAR_(); LAUNDER();
            ssdC_phase(p, gws, bid, nblk, l, smem);
            LAUNDER();
            { pg8::Gemm g{(const bf16_t*)(gws + OFF_SCPRE), wt + E_WSC, MS, 1024, 1024}; S.init(MS, 1024, nblk, bid);
              EpiGate1 E{(bf16_t*)(gws + OFF_T1), (const bf16_t*)(gws + OFF_G) + 1024}; pg8::gemm_phase(lds, g, S, E); }
            BAR_(); LAUNDER();
            { pg8::Gemm g{(const bf16_t*)(gws + OFF_SSDN), wt + E_WSSD, MS, 1024, 2048}; S.init(MS, 1024, nblk, bid);
              EpiGate2 E{(bf16_t*)(gws + OFF_MIXIN), (const bf16_t*)(gws + OFF_T1), (const bf16_t*)(gws + OFF_G)}; pg8::gemm_phase(lds, g, S, E); }
            BAR_(); LAUNDER();
            { pg8::Gemm g{(const bf16_t*)(gws + OFF_MIXIN), wt + E_WO, MS, 1024, 1024}; S.init(MS, 1024, nblk, bid);
              EpiBf16 E{(bf16_t*)(gws + OFF_MIX), 1024}; pg8::gemm_phase(lds, g, S, E); }
            BAR_(); LAUNDER();
            if (l == 0) resnorm_phase<true, true, false, true>(p.in[0], (const bf16_t*)(gws + OFF_MIX), p.out, H, mod + 2048, p.in[5] + l * 1024, p.in[17] + l * 1024, mod + 4096, mod + 3072, row0, bid, nblk);
            else resnorm_phase<true, true, true, true>(p.out, (const bf16_t*)(gws + OFF_MIX), p.out, H, mod + 2048, p.in[5] + l * 1024, p.in[17] + l * 1024, mod + 4096, mod + 3072, row0, bid, nblk);
            BAR_(); LAUNDER();
            { constexpr int NMT = (MS + 247) / 248;
              pg8::Gemm g{H, wt + E_WUP, NMT * 256, 5632, 1024}; S.init(NMT * 256, 5632, nblk, bid);
              EpiFfn E{(bf16_t*)(gws + OFF_ACT), p.in[20] + (size_t)l * 3 * 5632, p.in[21] + (size_t)l * 5632}; pg8::gemm_phase<EpiFfn, true>(lds, g, S, E); }
            BAR_(); LAUNDER();
            { pg8::Gemm g{(const bf16_t*)(gws + OFF_ACT), wt + E_WDN, MS, 1024, 2816}; S.init(MS, 1024, nblk, bid);
              EpiBf16 E{(bf16_t*)(gws + OFF_F), 1024}; pg8::gemm_phase(lds, g, S, E); }
            BAR_(); LAUNDER();
            if (l == 0) {
                resnorm_phase<true, true, true, true>(p.out, (const bf16_t*)(gws + OFF_F), p.out, H, mod + 5120, p.in[18] + l * 1024, p.in[4] + 1024, mod1 + 1024, mod1, row0, bid, nblk);
            } else {
                resnorm_phase<true, false, true, false>(p.out, (const bf16_t*)(gws + OFF_F), p.out, nullptr, mod + 5120, p.in[18] + l * 1024, nullptr, nullptr, nullptr, row0, bid, nblk);
                if (si + 1 < NSL / NGRP)
                    resnorm_phase<false, true>(p.in[0], nullptr, nullptr, H, nullptr, nullptr, p.in[4], modb + 1024, modb, (sl + NGRP) * MS, bid, nblk);
            }
            if (!(l == DEPTH - 1 && si + 1 == NSL / NGRP)) { BAR_(); }
            LAUNDER();
        }
    }
#undef mod
#undef mod1
#undef wt
#undef row0
#undef LAUNDER
#undef BAR_
}

extern "C" void kernel_launch(void* const* d_in, const int* in_sizes, int n_in, void* d_out, int out_size, void* d_ws, size_t ws_size, hipStream_t stream) {
    static int grid_blocks = 0;
    if (grid_blocks == 0) {
        if (n_in != 23 || ws_size < WS_NEED) { fprintf(stderr, "kernel_launch: need 23 inputs and %zu B workspace, got %d / %zu\n", (size_t)WS_NEED, n_in, ws_size); grid_blocks = -1; return; }
        int dev = 0, cus = 0, per_cu = 0;
        (void)hipGetDevice(&dev);
        (void)hipDeviceGetAttribute(&cus, hipDeviceAttributeMultiprocessorCount, dev);
        if (hipFuncSetAttribute((const void*)fwd_megakernel, hipFuncAttributeMaxDynamicSharedMemorySize, LDS_BYTES) != hipSuccess) { fprintf(stderr, "kernel_launch: hipFuncSetAttribute failed\n"); grid_blocks = -1; return; }
        if (hipOccupancyMaxActiveBlocksPerMultiprocessor(&per_cu, (const void*)fwd_megakernel, 512, LDS_BYTES) != hipSuccess || per_cu < 1) { fprintf(stderr, "kernel_launch: occupancy query failed (%d)\n", per_cu); (void)hipGetLastError(); }
        if (cus < NGRP * GBLK) { fprintf(stderr, "kernel_launch: built for %d CUs, device has %d\n", NGRP * GBLK, cus); grid_blocks = -1; return; }
        grid_blocks = NGRP * GBLK;
    }
    if (grid_blocks < 0) return;
    Params p{};
    for (int i = 0; i < 23; ++i) p.in[i] = (const float*)d_in[i];
    p.out = (float*)d_out; p.ws = (unsigned char*)d_ws;
    p.ph_lo = 0; p.ph_hi = 0;
    void* args[] = {&p};
    hipError_t e = hipLaunchCooperativeKernel((const void*)fwd_megakernel, dim3(grid_blocks), dim3(512), args, LDS_BYTES, stream);
    if (e != hipSuccess) fprintf(stderr, "cooperative launch failed: %s (grid %d)\n", hipGetErrorString(e), grid_blocks);
}
```

```cpp
#include <hip/hip_runtime.h>
#include <hip/hip_cooperative_groups.h>
#include <cstdio>
namespace cg = cooperative_groups;


typedef unsigned short bf16_t;
typedef short bf16x8 __attribute__((ext_vector_type(8)));
typedef float f32x4 __attribute__((ext_vector_type(4)));
typedef float f32x2 __attribute__((ext_vector_type(2)));
typedef unsigned u32x2 __attribute__((ext_vector_type(2)));
typedef unsigned u32x4 __attribute__((ext_vector_type(4)));
#define LAS __attribute__((address_space(3)))

constexpr int DM = 1024, SEQ = 4096, NBATCH = 16, DEPTH = 2;
constexpr int DI = 2048, NH = 32, NG = 4, DS = 128, CONVD = 3072, LCH = 128, NCH = 32, DFF = 2816;
constexpr int DINP = 10272, NPI = 10496;
#ifndef MK_NGRP
#define MK_NGRP 8
#endif
constexpr int NGRP = MK_NGRP, GBLK = 256 / NGRP, XPG = 8 / NGRP;
constexpr int SB = NBATCH / (2 * NGRP), MS = SB * SEQ, NSL = NBATCH / SB;
constexpr float EPS = 1e-6f;
constexpr int LDS_BYTES = 131072 + 16;

constexpr size_t E_WIN = 0, E_WSSD = (size_t)NPI * 1024, E_WSC = E_WSSD + 1024 * 2048, E_WO = E_WSC + 1024 * 1024,
                 E_WUP = E_WO + 1024 * 1024, E_WDN = E_WUP + (size_t)5632 * 1024, E_WLAYER = E_WDN + (size_t)1024 * 2816;
constexpr size_t OFF_WT = 0;
constexpr size_t OFF_MOD = OFF_WT + 2 * E_WLAYER * 2;
constexpr size_t OFF_BAR = OFF_MOD + 2 * 16 * 6144 * 4;
constexpr size_t BAR_BYTES = 8 * 16384;
constexpr size_t OFF_GRP = OFF_BAR + BAR_BYTES;
constexpr size_t OFF_CD = 0;
constexpr size_t OFF_H = OFF_CD + SB * 32 * 32 * 4;
constexpr size_t OFF_AR = OFF_H + (size_t)MS * 1024 * 2;
constexpr size_t OFF_Z = OFF_AR;
constexpr size_t OFF_XBC = OFF_Z + (size_t)MS * 2048 * 2;
constexpr size_t OFF_SCB = OFF_XBC + (size_t)MS * 3072 * 2;
constexpr size_t OFF_CHB = OFF_SCB + (size_t)MS * 1024 * 2;
constexpr size_t OFF_G = OFF_CHB + (size_t)MS * 1024 * 2;
constexpr size_t OFF_DT = OFF_G + (size_t)MS * 2048 * 2;
constexpr size_t OFF_YP = OFF_DT + (size_t)MS * 32 * 4;
constexpr size_t OFF_ST = OFF_YP + (size_t)MS * 2048 * 2;
constexpr size_t OFF_END1 = OFF_ST + (size_t)SB * 32 * 32 * 8192 * 2;
constexpr size_t OFF_SSDN = OFF_YP;
constexpr size_t OFF_SCPRE = OFF_SCB;
constexpr size_t OFF_T1 = OFF_CHB;
constexpr size_t OFF_MIXIN = OFF_XBC + (size_t)MS * 1024 * 2;
constexpr size_t OFF_MIX = OFF_Z;
constexpr size_t OFF_U = OFF_AR;
constexpr size_t OFF_ACT = OFF_U + (size_t)MS * 5632 * 2;
constexpr size_t OFF_F = OFF_ACT + (size_t)MS * 2816 * 2;
constexpr size_t OFF_END2 = OFF_F + (size_t)MS * 1024 * 2;
constexpr size_t GSTRIDE = OFF_END1 > OFF_END2 ? OFF_END1 : OFF_END2;
constexpr size_t WS_NEED = OFF_GRP + NGRP * GSTRIDE;
static_assert(OFF_MIXIN + (size_t)MS * 1024 * 2 <= OFF_SCB, "T1 + MIXIN must fit inside the dead XBC region");

struct Params {
    const float* in[23];
    float* out;
    unsigned char* ws;
    int ph_lo, ph_hi;
};

typedef __bf16 bf16x2_t __attribute__((ext_vector_type(2)));
__device__ __forceinline__ unsigned pk_bf16(float lo, float hi) { const f32x2 v = {lo, hi}; const bf16x2_t b = __builtin_convertvector(v, bf16x2_t); return __builtin_bit_cast(unsigned, b); }
__device__ __forceinline__ float bf_lo(unsigned u) { return __uint_as_float(u << 16); }
__device__ __forceinline__ float bf_hi(unsigned u) { return __uint_as_float(u & 0xffff0000u); }
__device__ __forceinline__ float fsigmoid(float x) { return __builtin_amdgcn_rcpf(1.0f + __expf(-x)); }
__device__ __forceinline__ float fsilu(float x) { return x * fsigmoid(x); }
__device__ __forceinline__ float wave_sum(float v) {
#pragma unroll
    for (int o = 32; o >= 1; o >>= 1) v += __shfl_xor(v, o);
    return v;
}
__device__ __forceinline__ int perm32(int rho) { const int n = rho >> 4, i = rho & 15; return 8 * (i >> 2) + 4 * n + (i & 3); }
__device__ __forceinline__ int inproj_src(int L) {
    if (L < 5120) return L;
    if (L < 6144) return 5152 + (L - 5120);
    if (L < 8192) { const int q = L - 6144, j = q >> 3, e = q & 7; return (e < 4 ? 6176 : 7200) + 4 * j + (e & 3); }
    if (L < 10240) return 8224 + (L - 8192);
    if (L < 10272) return 5120 + (L - 10240);
    return -1;
}

namespace pg8 {
constexpr int BM = 256, BK = 64, HALF = 128, HTB = HALF * BK * 2, NXCD = 8, WGM = 4;
__device__ __forceinline__ int lds_byte(int r, int c) { const int st = (r >> 4) * 2 + (c >> 5), rr = r & 15, cc = c & 31, ob = rr * 64 + cc * 2; return st * 1024 + (ob ^ (((ob >> 9) & 1) << 5)); }
__device__ __forceinline__ void stage_rc(int b, int& R, int& C) { const int st = b / 1024, sb = b % 1024, swz = sb ^ (((sb >> 9) & 1) << 5); R = (st >> 1) * 16 + swz / 64; C = (st & 1) * 32 + (swz % 64) / 2; }
struct Unit { int pm, pn; };
struct Gemm { const bf16_t* A; const bf16_t* Bt; int M, N, K; };
struct StaticOrder {
    int nM, nN, nwg, G, c;
    static constexpr int NX = XPG;
    __device__ void init(int M, int N, int G_, int c_) { nM = M / BM; nN = N / BM; nwg = nM * nN; G = G_; c = c_; }
    __device__ bool next(int i, Unit& u) const {
        const long L = (long)i * G + c; if (L >= nwg) return false;
        int wgid = (int)L; { const int q = nwg / NX, r = nwg % NX, xcd = wgid % NX, off = wgid / NX; wgid = (xcd < r ? xcd * (q + 1) : r * (q + 1) + (xcd - r) * q) + off; }
        const int nig = WGM * nN, gid = wgid / nig, fm = gid * WGM, gsz = (nM - fm) < WGM ? (nM - fm) : WGM;
        u.pm = fm + ((wgid % nig) % gsz); u.pn = (wgid % nig) / gsz; return true;
    }
};

template <class Epi, bool OVL = false>
__device__ __forceinline__ void gemm_phase(LAS unsigned char* lds, const Gemm g, const StaticOrder& S, const Epi& E) {
    int tid_ = threadIdx.x; asm volatile("" : "+v"(tid_));
    const int tid = tid_, wid = __builtin_amdgcn_readfirstlane(tid >> 6), lane = tid & 63, wr = wid >> 2, wc = wid & 3, fr = lane & 15, fq = lane >> 4;
    const int K = g.K, nt = K / BK;
    int voffA[2], voffB[2];
#pragma unroll
    for (int i = 0; i < 2; ++i) { int R, C; stage_rc(tid * 16 + i * 8192, R, C); voffB[i] = (R * K + C) * 2; voffA[i] = OVL ? ((62 * (R >> 6) + (R & 63) - 2) * K + C) * 2 : voffB[i]; }
    const size_t kstep = (size_t)(BK * 2);
    const size_t hstep = (size_t)HALF * K * 2;
    const size_t tstep = 2 * hstep;
    const size_t hstepA = OVL ? (size_t)124 * K * 2 : hstep, tstepA = 2 * hstepA;
    const unsigned ldsw = (unsigned)wid * 1024u;
    const int aoff = lds_byte(wr * 64 + fr, fq * 8), boff = lds_byte(wc * 32 + fr, fq * 8);
#define PG8_SA(b, h) (((b) * 2 + (h)) * HTB)
#define PG8_SB(b, h) ((4 + (b) * 2 + (h)) * HTB)
#define PG8_STAGEX(bufoff, gbase, voff) do { _Pragma("unroll") for (int _i = 0; _i < 2; ++_i) \
        __builtin_amdgcn_global_load_lds((const unsigned*)((const char*)(gbase) + (long)(voff)[_i]), (LAS unsigned*)(lds + (bufoff) + ldsw + _i * 8192), 16, 0, 0); } while (0)
#define PG8_STAGEA(bufoff, gbase) PG8_STAGEX(bufoff, gbase, voffA)
#define PG8_STAGEB(bufoff, gbase) PG8_STAGEX(bufoff, gbase, voffB)
#define PG8_LDA(dst, b, h) do { _Pragma("unroll") for (int m = 0; m < 4; ++m) _Pragma("unroll") for (int k = 0; k < 2; ++k) dst[m][k] = *(const LAS bf16x8*)(lds + PG8_SA(b, h) + aoff + m * 2048 + k * 1024); } while (0)
#define PG8_LDB(dst, b, h) do { _Pragma("unroll") for (int n = 0; n < 2; ++n) _Pragma("unroll") for (int k = 0; k < 2; ++k) dst[n][k] = *(const LAS bf16x8*)(lds + PG8_SB(b, h) + boff + n * 2048 + k * 1024); } while (0)
#define PG8_MMA(ai, bj, At, Bt) do { __builtin_amdgcn_s_setprio(1); _Pragma("unroll") for (int m = 0; m < 4; ++m) _Pragma("unroll") for (int n = 0; n < 2; ++n) _Pragma("unroll") for (int k = 0; k < 2; ++k) \
        acc[ai][bj][m][n] = __builtin_amdgcn_mfma_f32_16x16x32_bf16(Bt[n][k], At[m][k], acc[ai][bj][m][n], 0, 0, 0); __builtin_amdgcn_s_setprio(0); } while (0)
#define PG8_WAIT_V(n) asm volatile("s_waitcnt vmcnt(" #n ")" ::: "memory")
#define PG8_WAIT_L(n) asm volatile("s_waitcnt lgkmcnt(" #n ")" ::: "memory")
#define PG8_BAR __builtin_amdgcn_s_barrier()
#define PG8_SCHED __builtin_amdgcn_sched_barrier(0)
    Unit cur, nxt; int ui = 0;
    if (!S.next(0, cur)) return;
    f32x4 acc[2][2][4][2];
#pragma unroll
    for (int a = 0; a < 2; ++a)
#pragma unroll
        for (int b = 0; b < 2; ++b)
#pragma unroll
            for (int m = 0; m < 4; ++m)
#pragma unroll
                for (int n = 0; n < 2; ++n) acc[a][b][m][n] = (f32x4){0.f, 0.f, 0.f, 0.f};
    bf16x8 At[4][2], B0[2][2], B1[2][2];
    const char* cA = (const char*)g.A + (size_t)cur.pm * tstepA; const char* cB = (const char*)g.Bt + (size_t)cur.pn * tstep;
    PG8_STAGEB(PG8_SB(0, 0), cB); PG8_STAGEA(PG8_SA(0, 0), cA); PG8_STAGEB(PG8_SB(0, 1), cB + hstep); PG8_STAGEA(PG8_SA(0, 1), cA + hstepA);
    if (wr == 1) PG8_BAR;
    PG8_WAIT_V(4); PG8_BAR;
    PG8_STAGEB(PG8_SB(1, 0), cB + kstep); PG8_STAGEA(PG8_SA(1, 0), cA + kstep); PG8_STAGEB(PG8_SB(1, 1), cB + hstep + kstep);
    PG8_WAIT_V(6); PG8_BAR;
    for (;;) {
        const bool has_next = S.next(ui + 1, nxt);
        const char* nA = has_next ? (const char*)g.A + (size_t)nxt.pm * tstepA : cA; const char* nB = has_next ? (const char*)g.Bt + (size_t)nxt.pn * tstep : cB;
        for (int t = 0; t < nt; t += 2) {
            const bool last = (t == nt - 2);
            const char* a1 = cA + (size_t)(t + 1) * kstep;
            const char* a2 = last ? nA : cA + (size_t)(t + 2) * kstep; const char* b2 = last ? nB : cB + (size_t)(t + 2) * kstep;
            const char* a3 = a2 + kstep; const char* b3 = b2 + kstep;
            PG8_LDB(B0, 0, 0); PG8_SCHED; PG8_LDA(At, 0, 0); PG8_STAGEA(PG8_SA(1, 1), a1 + hstepA);
            PG8_WAIT_L(8); PG8_BAR; PG8_WAIT_L(0); PG8_MMA(0, 0, At, B0); PG8_BAR; PG8_SCHED;
            PG8_LDB(B1, 0, 1); PG8_STAGEB(PG8_SB(0, 0), b2);
            PG8_BAR; PG8_WAIT_L(0); PG8_MMA(0, 1, At, B1); PG8_BAR;
            PG8_LDA(At, 0, 1); PG8_STAGEA(PG8_SA(0, 0), a2);
            PG8_BAR; PG8_WAIT_L(0); PG8_MMA(1, 0, At, B0); PG8_BAR; PG8_SCHED;
            PG8_STAGEB(PG8_SB(0, 1), b2 + hstep);
            PG8_WAIT_V(6); PG8_BAR; PG8_MMA(1, 1, At, B1); PG8_BAR;
            PG8_LDB(B0, 1, 0); PG8_SCHED; PG8_LDA(At, 1, 0); PG8_STAGEA(PG8_SA(0, 1), a2 + hstepA);
            PG8_WAIT_L(8); PG8_BAR; PG8_WAIT_L(0); PG8_MMA(0, 0, At, B0); PG8_BAR; PG8_SCHED;
            PG8_LDB(B1, 1, 1); PG8_STAGEB(PG8_SB(1, 0), b3);
            PG8_BAR; PG8_WAIT_L(0); PG8_MMA(0, 1, At, B1); PG8_BAR;
            PG8_LDA(At, 1, 1); PG8_STAGEA(PG8_SA(1, 0), a3);
            PG8_BAR; PG8_WAIT_L(0); PG8_MMA(1, 0, At, B0); PG8_BAR; PG8_SCHED;
            PG8_STAGEB(PG8_SB(1, 1), b3 + hstep);
            PG8_WAIT_V(6); PG8_BAR; PG8_MMA(1, 1, At, B1); PG8_BAR;
        }
        E(acc, cur, wr, wc, fr, fq);
        if (!has_next) break;
#pragma unroll
        for (int a = 0; a < 2; ++a)
#pragma unroll
            for (int b = 0; b < 2; ++b)
#pragma unroll
                for (int m = 0; m < 4; ++m)
#pragma unroll
                    for (int n = 0; n < 2; ++n) acc[a][b][m][n] = (f32x4){0.f, 0.f, 0.f, 0.f};
        cur = nxt; cA = nA; cB = nB; ++ui;
    }
    PG8_WAIT_V(0);
    if (wr == 0) PG8_BAR;
    PG8_BAR;
#undef PG8_SA
#undef PG8_SB
#undef PG8_STAGEX
#undef PG8_STAGEA
#undef PG8_STAGEB
#undef PG8_LDA
#undef PG8_LDB
#undef PG8_MMA
#undef PG8_WAIT_V
#undef PG8_WAIT_L
#undef PG8_BAR
#undef PG8_SCHED
}
}

struct EpiF32 {
    float* C; int ld;
    __device__ __forceinline__ void operator()(const f32x4 (&acc)[2][2][4][2], const pg8::Unit& u, int wr, int wc, int fr, int fq) const {
        const int row0 = u.pm * 256 + wr * 64 + fr, col0 = u.pn * 256 + wc * 32 + 4 * fq;
#pragma unroll
        for (int ai = 0; ai < 2; ++ai)
#pragma unroll
            for (int m = 0; m < 4; ++m) { float* rowp = C + (size_t)(row0 + ai * 128 + m * 16) * ld + col0;
#pragma unroll
                for (int bj = 0; bj < 2; ++bj)
#pragma unroll
                    for (int n = 0; n < 2; ++n) *(f32x4*)(rowp + bj * 128 + n * 16) = acc[ai][bj][m][n]; }
    }
};
struct EpiGate1 {
    bf16_t* C; const bf16_t* G;
    __device__ __forceinline__ void operator()(const f32x4 (&acc)[2][2][4][2], const pg8::Unit& u, int wr, int wc, int fr, int fq) const {
        const int row0 = u.pm * 256 + wr * 64 + fr, col0 = u.pn * 256 + wc * 32 + 8 * fq;
#pragma unroll
        for (int ai = 0; ai < 2; ++ai)
#pragma unroll
            for (int m = 0; m < 4; ++m) { const size_t r = (size_t)(row0 + ai * 128 + m * 16);
#pragma unroll
                for (int bj = 0; bj < 2; ++bj) { const int c = col0 + bj * 128; const u32x4 gv = *(const u32x4*)(G + r * 2048 + c); const f32x4 a0 = acc[ai][bj][m][0], a1 = acc[ai][bj][m][1];
                    u32x4 w; w.x = pk_bf16(a0[0] * bf_lo(gv.x), a0[1] * bf_hi(gv.x)); w.y = pk_bf16(a0[2] * bf_lo(gv.y), a0[3] * bf_hi(gv.y));
                    w.z = pk_bf16(a1[0] * bf_lo(gv.z), a1[1] * bf_hi(gv.z)); w.w = pk_bf16(a1[2] * bf_lo(gv.w), a1[3] * bf_hi(gv.w));
                    *(u32x4*)(C + r * 1024 + c) = w; } }
    }
};
struct EpiGate2 {
    bf16_t* O; const bf16_t* T1; const bf16_t* G;
    __device__ __forceinline__ void operator()(const f32x4 (&acc)[2][2][4][2], const pg8::Unit& u, int wr, int wc, int fr, int fq) const {
        const int row0 = u.pm * 256 + wr * 64 + fr, col0 = u.pn * 256 + wc * 32 + 8 * fq;
#pragma unroll
        for (int ai = 0; ai < 2; ++ai)
#pragma unroll
            for (int m = 0; m < 4; ++m) { const size_t r = (size_t)(row0 + ai * 128 + m * 16);
#pragma unroll
                for (int bj = 0; bj < 2; ++bj) { const int c = col0 + bj * 128; const u32x4 gv = *(const u32x4*)(G + r * 2048 + c); const u32x4 tv = *(const u32x4*)(T1 + r * 1024 + c);
                    const f32x4 a0 = acc[ai][bj][m][0], a1 = acc[ai][bj][m][1];
                    u32x4 w; w.x = pk_bf16(bf_lo(tv.x) + a0[0] * bf_lo(gv.x), bf_hi(tv.x) + a0[1] * bf_hi(gv.x)); w.y = pk_bf16(bf_lo(tv.y) + a0[2] * bf_lo(gv.y), bf_hi(tv.y) + a0[3] * bf_hi(gv.y));
                    w.z = pk_bf16(bf_lo(tv.z) + a1[0] * bf_lo(gv.z), bf_hi(tv.z) + a1[1] * bf_hi(gv.z)); w.w = pk_bf16(bf_lo(tv.w) + a1[2] * bf_lo(gv.w), bf_hi(tv.w) + a1[3] * bf_hi(gv.w));
                    *(u32x4*)(O + r * 1024 + c) = w; } }
    }
};
struct EpiBf16 {
    bf16_t* O; int ld;
    __device__ __forceinline__ void operator()(const f32x4 (&acc)[2][2][4][2], const pg8::Unit& u, int wr, int wc, int fr, int fq) const {
        const int row0 = u.pm * 256 + wr * 64 + fr, col0 = u.pn * 256 + wc * 32 + 8 * fq;
#pragma unroll
        for (int ai = 0; ai < 2; ++ai)
#pragma unroll
            for (int m = 0; m < 4; ++m) { bf16_t* rowp = O + (size_t)(row0 + ai * 128 + m * 16) * ld + col0;
#pragma unroll
                for (int bj = 0; bj < 2; ++bj) { const f32x4 a0 = acc[ai][bj][m][0], a1 = acc[ai][bj][m][1];
                    u32x4 w; w.x = pk_bf16(a0[0], a0[1]); w.y = pk_bf16(a0[2], a0[3]); w.z = pk_bf16(a1[0], a1[1]); w.w = pk_bf16(a1[2], a1[3]);
                    *(u32x4*)(rowp + bj * 128) = w; } }
    }
};
template <int N> __device__ __forceinline__ float dpp_ror(float v) { return __builtin_bit_cast(float, __builtin_amdgcn_update_dpp(0, __builtin_bit_cast(int, v), 0x120 + N, 0xF, 0xF, false)); }
struct EpiFfn {
    bf16_t* ACT; const float* fw; const float* fb;
    __device__ __forceinline__ void operator()(const f32x4 (&acc)[2][2][4][2], const pg8::Unit& u, int wr, int wc, int fr, int fq) const {
#pragma unroll
        for (int bj = 0; bj < 2; ++bj) {
            const int ch0 = 4 * (32 * u.pn + 16 * bj + 4 * wc + fq);
            const f32x4 wg0 = *(const f32x4*)(fw + ch0), wg1 = *(const f32x4*)(fw + 5632 + ch0), wg2 = *(const f32x4*)(fw + 2 * 5632 + ch0), bg = *(const f32x4*)(fb + ch0);
            const f32x4 wv0 = *(const f32x4*)(fw + 2816 + ch0), wv1 = *(const f32x4*)(fw + 5632 + 2816 + ch0), wv2 = *(const f32x4*)(fw + 2 * 5632 + 2816 + ch0), bv = *(const f32x4*)(fb + 2816 + ch0);
#pragma unroll
            for (int ai = 0; ai < 2; ++ai) {
                const int rowblk = 248 * u.pm + 124 * ai + 62 * wr - 2;
                f32x4 g1p = (f32x4){0.f, 0.f, 0.f, 0.f}, g2p = g1p, v1p = g1p, v2p = g1p;
#pragma unroll
                for (int m = 0; m < 4; ++m) {
                    const f32x4 cg = acc[ai][bj][m][0], cv = acc[ai][bj][m][1];
                    f32x4 g1c, g2c, v1c, v2c;
#pragma unroll
                    for (int e = 0; e < 4; ++e) { g1c[e] = dpp_ror<1>(cg[e]); g2c[e] = dpp_ror<2>(cg[e]); v1c[e] = dpp_ror<1>(cv[e]); v2c[e] = dpp_ror<2>(cv[e]); }
                    const int rho = 16 * m + fr, grow = rowblk + rho, pos = grow & 4095;
                    f32x4 pg1, pg2, pv1, pv2;
#pragma unroll
                    for (int e = 0; e < 4; ++e) { pg1[e] = fr >= 1 ? g1c[e] : g1p[e]; pg2[e] = fr >= 2 ? g2c[e] : g2p[e]; pv1[e] = fr >= 1 ? v1c[e] : v1p[e]; pv2[e] = fr >= 2 ? v2c[e] : v2p[e]; }
                    if (__builtin_amdgcn_ballot_w64(pos <= 1) != 0ull) {
#pragma unroll
                        for (int e = 0; e < 4; ++e) { if (pos == 0) { pg1[e] = 0.f; pv1[e] = 0.f; } if (pos <= 1) { pg2[e] = 0.f; pv2[e] = 0.f; } } }
                    float o[4];
#pragma unroll
                    for (int e = 0; e < 4; ++e) { const float ug = bg[e] + wg0[e] * pg2[e] + wg1[e] * pg1[e] + wg2[e] * cg[e]; const float uv = bv[e] + wv0[e] * pv2[e] + wv1[e] * pv1[e] + wv2[e] * cv[e]; o[e] = fsilu(ug) * uv; }
                    if (rho >= 2 && grow < MS) { u32x2 w; w.x = pk_bf16(o[0], o[1]); w.y = pk_bf16(o[2], o[3]); *(u32x2*)(ACT + (size_t)grow * 2816 + ch0) = w; }
                    g1p = g1c; g2p = g2c; v1p = v1c; v2p = v2c;
                }
            }
        }
    }
};
struct EpiInProj {
    bf16_t *Z, *XBC, *SCB, *CHB, *G; float* DT; const float* dt_bias;
    __device__ __forceinline__ void operator()(const f32x4 (&acc)[2][2][4][2], const pg8::Unit& u, int wr, int wc, int fr, int fq) const {
        const int row0 = u.pm * 256 + wr * 64 + fr, col0 = u.pn * 256 + wc * 32 + 8 * fq; const int pn = u.pn;
#pragma unroll
        for (int ai = 0; ai < 2; ++ai)
#pragma unroll
            for (int m = 0; m < 4; ++m) { const size_t r = (size_t)(row0 + ai * 128 + m * 16);
#pragma unroll
                for (int bj = 0; bj < 2; ++bj) { const int c = col0 + bj * 128; f32x4 a0 = acc[ai][bj][m][0], a1 = acc[ai][bj][m][1];
                    if (pn < 8) {
#pragma unroll
                        for (int e = 0; e < 4; ++e) { a0[e] = fsilu(a0[e]); a1[e] = fsilu(a1[e]); }
                        u32x4 w; w.x = pk_bf16(a0[0], a0[1]); w.y = pk_bf16(a0[2], a0[3]); w.z = pk_bf16(a1[0], a1[1]); w.w = pk_bf16(a1[2], a1[3]);
                        __builtin_nontemporal_store(w, (u32x4*)(Z + r * 2048 + c));
                    } else if (pn < 20) {
                        u32x4 w; w.x = pk_bf16(a0[0], a0[1]); w.y = pk_bf16(a0[2], a0[3]); w.z = pk_bf16(a1[0], a1[1]); w.w = pk_bf16(a1[2], a1[3]);
                        *(u32x4*)(XBC + r * 3072 + (c - 2048)) = w;
                    } else if (pn < 24) {
                        u32x4 w; w.x = pk_bf16(a0[0], a0[1]); w.y = pk_bf16(a0[2], a0[3]); w.z = pk_bf16(a1[0], a1[1]); w.w = pk_bf16(a1[2], a1[3]);
                        *(u32x4*)(SCB + r * 1024 + (c - 5120)) = w;
                    } else if (pn < 32) {
                        u32x2 w; w.x = pk_bf16(a0[0] * a1[0], a0[1] * a1[1]); w.y = pk_bf16(a0[2] * a1[2], a0[3] * a1[3]);
                        *(u32x2*)(CHB + r * 1024 + ((c - 6144) >> 1)) = w;
                    } else if (pn < 40) {
#pragma unroll
                        for (int e = 0; e < 4; ++e) { a0[e] = fsigmoid(a0[e]); a1[e] = fsigmoid(a1[e]); }
                        u32x4 w; w.x = pk_bf16(a0[0], a0[1]); w.y = pk_bf16(a0[2], a0[3]); w.z = pk_bf16(a1[0], a1[1]); w.w = pk_bf16(a1[2], a1[3]);
                        __builtin_nontemporal_store(w, (u32x4*)(G + r * 2048 + (c - 8192)));
                    } else {
                        if (bj == 0 && wc == 0) { const int h0 = 8 * fq; f32x4 o0, o1;
#pragma unroll
                            for (int e = 0; e < 4; ++e) { float x0 = a0[e] + dt_bias[h0 + e], x1 = a1[e] + dt_bias[h0 + 4 + e];
                                o0[e] = x0 > 20.f ? x0 : log1pf(expf(x0)); o1[e] = x1 > 20.f ? x1 : log1pf(expf(x1)); }
                            *(f32x4*)(DT + r * 32 + h0) = o0; *(f32x4*)(DT + r * 32 + h0 + 4) = o1; }
                    } } }
    }
};

struct CvtTile { const float* W; bf16_t* Wt; int K, N, kind, tile; };
__device__ __forceinline__ void convert_load(const CvtTile& c, float (&v)[8], int tid) {
    const int ntk = c.K >> 6; const int tn = c.tile / ntk, tk = c.tile - tn * ntk; const int n0 = tn * 64, k0 = tk * 64;
    const int nl = tid & 63, nphys = n0 + nl; int L = nphys;
    if (c.kind >= 1) L = (nphys & ~31) + perm32(nphys & 31);
    int src = (c.kind == 2) ? inproj_src(L) : L;
    if (c.kind == 3) { const int j = L >> 3, e = L & 7; src = (e < 4 ? 0 : 2816) + 4 * j + (e & 3); }
#pragma unroll
    for (int i = 0; i < 8; ++i) { const int k = (tid >> 6) + 8 * i; v[i] = (src >= 0 && src < c.N) ? c.W[(size_t)(k0 + k) * c.N + src] : 0.f; }
}
__device__ __forceinline__ void convert_stash(const float (&v)[8], float* tl, int tid) {
    const int nl = tid & 63;
#pragma unroll
    for (int i = 0; i < 8; ++i) { const int k = (tid >> 6) + 8 * i; tl[nl * 65 + k] = v[i]; }
}
__device__ __forceinline__ void convert_store(const CvtTile& c, const float* tl, int tid) {
    const int ntk = c.K >> 6; const int tn = c.tile / ntk, tk = c.tile - tn * ntk; const int n0 = tn * 64, k0 = tk * 64;
    const int nl = tid >> 3, k8 = (tid & 7) * 8; const float* s = tl + nl * 65 + k8;
    u32x4 w; w.x = pk_bf16(s[0], s[1]); w.y = pk_bf16(s[2], s[3]); w.z = pk_bf16(s[4], s[5]); w.w = pk_bf16(s[6], s[7]);
    *(u32x4*)(c.Wt + (size_t)(n0 + nl) * c.K + k0 + k8) = w;
}

__device__ __forceinline__ void mod_item(const Params& p, int item, float* sm) {
    int tid_ = threadIdx.x; asm volatile("" : "+v"(tid_));
    const int tid = tid_; const int l = item / 96, cgp = item - l * 96; const int kq = tid >> 6, j = tid & 63, col = cgp * 64 + j;
    float* cact = sm;
    float* red = sm + 16 * 1024;
    const float* c = p.in[1];
    for (int i = tid; i < 16 * 1024; i += 512) cact[(i & 1023) * 16 + (i >> 10)] = fsilu(c[i]);
    __syncthreads();
    const float* W = p.in[2] + (size_t)l * 1024 * 6144;
    float acc[16];
#pragma unroll
    for (int b = 0; b < 16; ++b) acc[b] = 0.f;
#pragma unroll 1
    for (int k0 = kq * 128; k0 < kq * 128 + 128; k0 += 16) {
        float wv[16];
#pragma unroll
        for (int u = 0; u < 16; ++u) wv[u] = W[(size_t)(k0 + u) * 6144 + col];
#pragma unroll
        for (int u = 0; u < 16; ++u) {
#pragma unroll
            for (int b4 = 0; b4 < 4; ++b4) { const f32x4 cv = *(const f32x4*)(cact + (k0 + u) * 16 + 4 * b4);
                acc[4 * b4 + 0] += cv[0] * wv[u]; acc[4 * b4 + 1] += cv[1] * wv[u]; acc[4 * b4 + 2] += cv[2] * wv[u]; acc[4 * b4 + 3] += cv[3] * wv[u]; } }
    }
#pragma unroll
    for (int b = 0; b < 16; ++b) red[(kq * 16 + b) * 64 + j] = acc[b];
    __syncthreads();
    float* mod = (float*)(p.ws + OFF_MOD) + (size_t)l * 16 * 6144;
    const float bias = p.in[3][l * 6144 + col];
#pragma unroll
    for (int bb = 0; bb < 2; ++bb) { const int b = kq * 2 + bb; float s = bias;
#pragma unroll
        for (int q = 0; q < 8; ++q) s += red[(q * 16 + b) * 64 + j];
        mod[b * 6144 + col] = s; }
    __syncthreads();
}

__device__ __forceinline__ CvtTile prep_tile(const Params& p, int l, int t) {
    constexpr int T_WIN = (NPI / 64) * 16, T_WSSD = 16 * 32, T_WSC = 16 * 16, T_WO = 16 * 16, T_WUP = 88 * 16;
    bf16_t* wt = (bf16_t*)(p.ws + OFF_WT) + (size_t)l * E_WLAYER;
    if (t < T_WIN) return CvtTile{p.in[6] + (size_t)l * 1024 * DINP, wt + E_WIN, 1024, DINP, 2, t};
    t -= T_WIN;
    if (t < T_WSSD) return CvtTile{p.in[13] + (size_t)l * 2048 * 1024, wt + E_WSSD, 2048, 1024, 1, t};
    t -= T_WSSD;
    if (t < T_WSC) return CvtTile{p.in[15] + (size_t)l * 1024 * 1024, wt + E_WSC, 1024, 1024, 1, t};
    t -= T_WSC;
    if (t < T_WO) return CvtTile{p.in[16] + (size_t)l * 1024 * 1024, wt + E_WO, 1024, 1024, 1, t};
    t -= T_WO;
    if (t < T_WUP) return CvtTile{p.in[19] + (size_t)l * 1024 * 5632, wt + E_WUP, 1024, 5632, 3, t};
    t -= T_WUP;
    return CvtTile{p.in[22] + (size_t)l * 2816 * 1024, wt + E_WDN, 2816, 1024, 1, t};
}
__device__ __forceinline__ void prep_phase(const Params& p, float* sm, int lsel, int bid, int nblk) {
    constexpr int T_LAYER = (NPI / 64) * 16 + 16 * 32 + 16 * 16 + 16 * 16 + 88 * 16 + 16 * 44;
    constexpr int N_MOD = 192, NB = 3;
    int tid_ = threadIdx.x; asm volatile("" : "+v"(tid_));
    if (lsel == 0) for (int it = bid; it < N_MOD; it += nblk) mod_item(p, it, sm);
    for (int t0 = bid; t0 < T_LAYER; t0 += NB * nblk) {
        CvtTile c[NB]; float v[NB][8];
#pragma unroll
        for (int q = 0; q < NB; ++q) { const int t = t0 + q * nblk; c[q] = prep_tile(p, lsel, t < T_LAYER ? t : t0); convert_load(c[q], v[q], tid_); }
#pragma unroll
        for (int q = 0; q < NB; ++q) convert_stash(v[q], sm + q * (64 * 65), tid_);
        __syncthreads();
#pragma unroll
        for (int q = 0; q < NB; ++q) { const int t = t0 + q * nblk; if (t < T_LAYER) convert_store(c[q], sm + q * (64 * 65), tid_); }
        __syncthreads();
    }
}

template <bool HAS_Y, bool HAS_H, bool XIB = false, bool XOB = false>
__device__ __forceinline__ void resnorm_phase(const float* xin, const bf16_t* __restrict__ y, float* xout, bf16_t* __restrict__ hout,
                                              const float* __restrict__ gt, const float* __restrict__ postg, const float* __restrict__ preg,
                                              const float* __restrict__ scv, const float* __restrict__ shv, int row0, int bid, int nblk) {
    int tid_ = threadIdx.x; asm volatile("" : "+v"(tid_));
    const int lane = tid_ & 63, wid = tid_ >> 6;
    const int nw = nblk * 8;
    constexpr bool ONEB = (MS <= SEQ);
    f32x4 pA[4], pB[4], pS[4];
    if (ONEB) { const int b0 = row0 >> 12;
#pragma unroll
        for (int i = 0; i < 4; ++i) { const int col = (i * 64 + lane) * 4;
            if (HAS_Y) pA[i] = *(const f32x4*)(gt + b0 * 6144 + col) * *(const f32x4*)(postg + col);
            if (HAS_H) { pB[i] = *(const f32x4*)(preg + col) * (*(const f32x4*)(scv + b0 * 6144 + col) + 1.0f); pS[i] = *(const f32x4*)(shv + b0 * 6144 + col); } } }
    for (int rb = bid * 8 + wid; rb < MS; rb += 2 * nw) {
        f32x4 xv[2][4]; u32x2 yv[2][4];
#pragma unroll
        for (int q = 0; q < 2; ++q) { const int r = rb + q * nw; if (r < MS) {
#pragma unroll
            for (int i = 0; i < 4; ++i) {
                if (XIB) { const u32x2 xb = __builtin_nontemporal_load((const u32x2*)((const bf16_t*)(xin + (size_t)(row0 + r) * 1024) + (i * 64 + lane) * 4)); xv[q][i][0] = bf_lo(xb.x); xv[q][i][1] = bf_hi(xb.x); xv[q][i][2] = bf_lo(xb.y); xv[q][i][3] = bf_hi(xb.y); }
                else xv[q][i] = __builtin_nontemporal_load((const f32x4*)(xin + (size_t)(row0 + r) * 1024 + (i * 64 + lane) * 4));
                if (HAS_Y) yv[q][i] = __builtin_nontemporal_load((const u32x2*)(y + (size_t)r * 1024 + (i * 64 + lane) * 4)); } } }
#pragma unroll
        for (int q = 0; q < 2; ++q) { const int r = rb + q * nw; if (r < MS) {
            const int tok = row0 + r, b = tok >> 12;
            if (HAS_Y) {
                f32x4 yf[4]; float ss = 0.f;
#pragma unroll
                for (int i = 0; i < 4; ++i) { yf[i][0] = bf_lo(yv[q][i].x); yf[i][1] = bf_hi(yv[q][i].x); yf[i][2] = bf_lo(yv[q][i].y); yf[i][3] = bf_hi(yv[q][i].y); ss += yf[i][0] * yf[i][0] + yf[i][1] * yf[i][1] + yf[i][2] * yf[i][2] + yf[i][3] * yf[i][3]; }
                ss = wave_sum(ss);
                const float rinv = rsqrtf(ss * (1.0f / 1024.0f) + EPS);
#pragma unroll
                for (int i = 0; i < 4; ++i) { const int col = (i * 64 + lane) * 4;
                    if (ONEB) xv[q][i] = xv[q][i] + pA[i] * (yf[i] * rinv);
                    else { const f32x4 g = *(const f32x4*)(gt + b * 6144 + col), pg = *(const f32x4*)(postg + col); xv[q][i] = xv[q][i] + g * (yf[i] * rinv * pg); }
                    if (XOB) { u32x2 xw; xw.x = pk_bf16(xv[q][i][0], xv[q][i][1]); xw.y = pk_bf16(xv[q][i][2], xv[q][i][3]); __builtin_nontemporal_store(xw, (u32x2*)((bf16_t*)(xout + (size_t)tok * 1024) + col)); }
                    else __builtin_nontemporal_store(xv[q][i], (f32x4*)(xout + (size_t)tok * 1024 + col)); }
            }
            if (HAS_H) {
                float ss = 0.f;
#pragma unroll
                for (int i = 0; i < 4; ++i) ss += xv[q][i][0] * xv[q][i][0] + xv[q][i][1] * xv[q][i][1] + xv[q][i][2] * xv[q][i][2] + xv[q][i][3] * xv[q][i][3];
                ss = wave_sum(ss);
                const float rinv = rsqrtf(ss * (1.0f / 1024.0f) + EPS);
#pragma unroll
                for (int i = 0; i < 4; ++i) { const int col = (i * 64 + lane) * 4; f32x4 hv;
                    if (ONEB) hv = (xv[q][i] * rinv) * pB[i] + pS[i];
                    else { const f32x4 pg = *(const f32x4*)(preg + col), sc = *(const f32x4*)(scv + b * 6144 + col), sh = *(const f32x4*)(shv + b * 6144 + col); hv = (xv[q][i] * rinv * pg) * (sc + 1.0f) + sh; }
                    u32x2 w; w.x = pk_bf16(hv[0], hv[1]); w.y = pk_bf16(hv[2], hv[3]);
                    *(u32x2*)(hout + (size_t)r * 1024 + col) = w; }
            }
        } }
    }
}

__device__ __forceinline__ void ssd_acs(const float* __restrict__ DT, const float* __restrict__ a_log, int r0, int g, float* sAcs, float* sDtv, float* cd_out) {
    int tid_ = threadIdx.x; asm volatile("" : "+v"(tid_));
    const int lane = tid_ & 63, hh = tid_ >> 6, h = g * 8 + hh;
    const float a = -__expf(a_log[h]);
    const int l0 = 2 * lane;
    const float d0 = DT[(size_t)(r0 + l0) * 32 + h], d1 = DT[(size_t)(r0 + l0 + 1) * 32 + h];
    const float v0 = a * d0, v1 = a * d1, s = v0 + v1;
    float incl = s;
#pragma unroll
    for (int o = 1; o < 64; o <<= 1) { const float t = __shfl_up(incl, o); if (lane >= o) incl += t; }
    const float excl = incl - s;
    sAcs[hh * 128 + l0] = excl + v0; sAcs[hh * 128 + l0 + 1] = incl;
    if (sDtv) { sDtv[hh * 128 + l0] = d0; sDtv[hh * 128 + l0 + 1] = d1; }
    if (cd_out && lane == 63) cd_out[hh] = __expf(incl);
}

template <int NC>
__device__ __forceinline__ void conv_rows8(const bf16_t* __restrict__ XBC, const float* __restrict__ cw, const float* __restrict__ cb, int r0, int l0, int col, bool first, float (&o)[8][NC]) {
    float raw[11][NC];
#pragma unroll
    for (int i = 0; i < 11; ++i) {
        const bool zero = first && (l0 + i - 3 < 0);
        if constexpr (NC == 8) { u32x4 v = (u32x4){0u, 0u, 0u, 0u}; if (!zero) v = *(const u32x4*)(XBC + (size_t)(r0 + l0 + i - 3) * 3072 + col);
            raw[i][0] = bf_lo(v.x); raw[i][1] = bf_hi(v.x); raw[i][2] = bf_lo(v.y); raw[i][3] = bf_hi(v.y); raw[i][4] = bf_lo(v.z); raw[i][5] = bf_hi(v.z); raw[i][6] = bf_lo(v.w); raw[i][7] = bf_hi(v.w); }
        else { unsigned v = 0u; if (!zero) v = *(const unsigned*)(XBC + (size_t)(r0 + l0 + i - 3) * 3072 + col); raw[i][0] = bf_lo(v); raw[i][1] = bf_hi(v); }
    }
#pragma unroll
    for (int j = 0; j < NC; ++j) { const float w0 = cw[col + j], w1 = cw[3072 + col + j], w2 = cw[2 * 3072 + col + j], w3 = cw[3 * 3072 + col + j], bb = cb[col + j];
#pragma unroll
        for (int i = 0; i < 8; ++i) o[i][j] = fsilu(bb + w0 * raw[i][j] + w1 * raw[i + 1][j] + w2 * raw[i + 2][j] + w3 * raw[i + 3][j]); }
}


__device__ __forceinline__ void conv2_load(const bf16_t* __restrict__ XBC, const float* __restrict__ cw, const float* __restrict__ cb, int r0, int l0, int col, bool first, unsigned (&rv)[11], f32x2 (&wv)[5]) {
#pragma unroll
    for (int i = 0; i < 11; ++i) { const bool zero = first && (l0 + i - 3 < 0); unsigned v = 0u; if (!zero) v = *(const unsigned*)(XBC + (size_t)(r0 + l0 + i - 3) * 3072 + col); rv[i] = v; }
#pragma unroll
    for (int k = 0; k < 4; ++k) wv[k] = *(const f32x2*)(cw + k * 3072 + col);
    wv[4] = *(const f32x2*)(cb + col);
}
__device__ __forceinline__ void conv2_compute(const unsigned (&rv)[11], const f32x2 (&wv)[5], float (&o)[8][2]) {
    f32x2 r[11];
#pragma unroll
    for (int i = 0; i < 11; ++i) { r[i][0] = bf_lo(rv[i]); r[i][1] = bf_hi(rv[i]); }
#pragma unroll
    for (int i = 0; i < 8; ++i) { const f32x2 a = wv[4] + wv[0] * r[i] + wv[1] * r[i + 1] + wv[2] * r[i + 2] + wv[3] * r[i + 3];
        o[i][0] = fsilu(a[0]); o[i][1] = fsilu(a[1]); }
}

constexpr int LS = 136;

__device__ __forceinline__ void ssdA_phase(const Params& p, unsigned char* gws, int bid, int nblk, int l, unsigned char* smem) {
    int tid_ = threadIdx.x; asm volatile("" : "+v"(tid_));
    const int tid = tid_, lane = tid & 63, w = tid >> 6, fr = lane & 15, fq = lane >> 4;
    bf16_t* sC = (bf16_t*)smem; bf16_t* sB = sC + 128 * LS; bf16_t* sBt = sB + 128 * LS;
    float* sAcs = (float*)(smem + 3 * 128 * LS * 2); float* sDtv = sAcs + 8 * 128;
    const bf16_t* XBC = (const bf16_t*)(gws + OFF_XBC); const float* DT = (const float*)(gws + OFF_DT);
    bf16_t* YP = (bf16_t*)(gws + OFF_YP); bf16_t* ST = (bf16_t*)(gws + OFF_ST); float* CD = (float*)(gws + OFF_CD);
    const float* cw = p.in[7] + (size_t)l * 4 * 3072; const float* cb = p.in[8] + l * 3072;
    const float* a_log = p.in[10] + l * 32; const float* dsk = p.in[11] + l * 32;
    for (int item = bid; item < SB * 32 * 4; item += nblk) {
        const int bl = item >> 7, c = (item >> 2) & 31, g = item & 3; const int r0 = bl * 4096 + c * 128; const bool first = (c == 0);
        ssd_acs(DT, a_log, r0, g, sAcs, sDtv, CD + (bl * 32 + c) * 32 + g * 8);
        {
            const int cg8 = tid & 31, l0 = (tid >> 5) * 8, isC = cg8 >> 4, n0 = (cg8 & 15) * 8; const int col = 2048 + isC * 512 + g * 128 + n0;
            float o[8][8]; conv_rows8<8>(XBC, cw, cb, r0, l0, col, first, o);
            bf16_t* dst = isC ? sC : sB;
#pragma unroll
            for (int i = 0; i < 8; ++i) { u32x4 v; v.x = pk_bf16(o[i][0], o[i][1]); v.y = pk_bf16(o[i][2], o[i][3]); v.z = pk_bf16(o[i][4], o[i][5]); v.w = pk_bf16(o[i][6], o[i][7]);
                *(u32x4*)(dst + (l0 + i) * LS + n0) = v; }
            if (!isC) {
#pragma unroll
                for (int j = 0; j < 8; ++j) { u32x4 v; v.x = pk_bf16(o[0][j], o[1][j]); v.y = pk_bf16(o[2][j], o[3][j]); v.z = pk_bf16(o[4][j], o[5][j]); v.w = pk_bf16(o[6][j], o[7][j]);
                    *(u32x4*)(sBt + (n0 + j) * LS + l0) = v; }
            }
        }
        __syncthreads();
        f32x4 sacc[8];
#pragma unroll
        for (int st = 0; st < 8; ++st) sacc[st] = (f32x4){0.f, 0.f, 0.f, 0.f};
#pragma unroll
        for (int kk = 0; kk < 4; ++kk) { const bf16x8 a = *(const bf16x8*)(sC + (16 * w + fr) * LS + 32 * kk + 8 * fq);
#pragma unroll
            for (int st = 0; st < 8; ++st) { const bf16x8 b = *(const bf16x8*)(sB + (16 * st + fr) * LS + 32 * kk + 8 * fq);
                sacc[st] = __builtin_amdgcn_mfma_f32_16x16x32_bf16(b, a, sacc[st], 0, 0, 0); } }
        __syncthreads();
        unsigned rvn[11]; f32x2 wvn[5];
        const int p0 = (tid & 31) * 2, lx0 = (tid >> 5) * 8, colx = g * 512 + p0;
        conv2_load(XBC, cw, cb, r0, lx0, colx, first, rvn, wvn);
#define SSDA_CONVX(hx, XT_, XDT_) do { \
            unsigned rvc[11]; f32x2 wvc[5]; \
            _Pragma("unroll") for (int i = 0; i < 11; ++i) rvc[i] = rvn[i]; \
            _Pragma("unroll") for (int i = 0; i < 5; ++i) wvc[i] = wvn[i]; \
            if ((hx) < 7) conv2_load(XBC, cw, cb, r0, lx0, colx + ((hx) + 1) * 64, first, rvn, wvn); \
            float o[8][2]; conv2_compute(rvc, wvc, o); \
            const float alast = sAcs[(hx) * 128 + 127]; \
            float xd[8][2], xe[8][2]; \
            _Pragma("unroll") for (int i = 0; i < 8; ++i) { const float dtl = sDtv[(hx) * 128 + lx0 + i], de = __expf(alast - sAcs[(hx) * 128 + lx0 + i]); \
                xd[i][0] = o[i][0] * dtl; xd[i][1] = o[i][1] * dtl; xe[i][0] = xd[i][0] * de; xe[i][1] = xd[i][1] * de; } \
            _Pragma("unroll") for (int j = 0; j < 2; ++j) { u32x4 v; v.x = pk_bf16(xd[0][j], xd[1][j]); v.y = pk_bf16(xd[2][j], xd[3][j]); v.z = pk_bf16(xd[4][j], xd[5][j]); v.w = pk_bf16(xd[6][j], xd[7][j]); \
                *(u32x4*)((XT_) + (p0 + j) * LS + lx0) = v; \
                u32x4 e; e.x = pk_bf16(xe[0][j], xe[1][j]); e.y = pk_bf16(xe[2][j], xe[3][j]); e.z = pk_bf16(xe[4][j], xe[5][j]); e.w = pk_bf16(xe[6][j], xe[7][j]); \
                *(u32x4*)((XDT_) + (p0 + j) * LS + lx0) = e; } } while (0)
        bf16_t* sX = sC;
        SSDA_CONVX(0, sX, sX + 64 * LS);
        __syncthreads();
#pragma unroll 1
        for (int hh = 0; hh < 8; ++hh) {
            const int h = g * 8 + hh;
            const bf16_t* Xt_c = sX + (hh & 1) * (128 * LS); const bf16_t* Xdt_c = Xt_c + 64 * LS;
            if (hh < 7) { bf16_t* Xt_n = sX + ((hh + 1) & 1) * (128 * LS); SSDA_CONVX(hh + 1, Xt_n, Xt_n + 64 * LS); }
            {
                const int lrow = 16 * w + fr; const float acs_l = sAcs[hh * 128 + lrow]; const float dsk_dt = dsk[h] / fmaxf(sDtv[hh * 128 + lrow], 1e-30f);
                f32x4 yacc[4];
#pragma unroll
                for (int pt = 0; pt < 4; ++pt) yacc[pt] = (f32x4){0.f, 0.f, 0.f, 0.f};
                const int kkmax = w >> 1;
#pragma unroll
                for (int kk = 0; kk < 4; ++kk) { if (kk <= kkmax) {
                        const f32x4 as0 = *(const f32x4*)(sAcs + hh * 128 + 32 * kk + 4 * fq), as1 = *(const f32x4*)(sAcs + hh * 128 + 32 * kk + 16 + 4 * fq);
                        float mv[8];
#pragma unroll
                        for (int e = 0; e < 4; ++e) { const int s0 = 32 * kk + 4 * fq + e, s1 = s0 + 16;
                            float m0 = (s0 <= lrow) ? sacc[2 * kk][e] * __expf(fminf(acs_l - as0[e], 0.f)) : 0.f; if (s0 == lrow) m0 += dsk_dt;
                            float m1 = (s1 <= lrow) ? sacc[2 * kk + 1][e] * __expf(fminf(acs_l - as1[e], 0.f)) : 0.f; if (s1 == lrow) m1 += dsk_dt;
                            mv[e] = m0; mv[4 + e] = m1; }
                        u32x4 mk; mk.x = pk_bf16(mv[0], mv[1]); mk.y = pk_bf16(mv[2], mv[3]); mk.z = pk_bf16(mv[4], mv[5]); mk.w = pk_bf16(mv[6], mv[7]);
                        const bf16x8 a = __builtin_bit_cast(bf16x8, mk);
#pragma unroll
                        for (int pt = 0; pt < 4; ++pt) { const u32x2 lo = *(const u32x2*)(Xt_c + (16 * pt + fr) * LS + 32 * kk + 4 * fq), hi = *(const u32x2*)(Xt_c + (16 * pt + fr) * LS + 32 * kk + 16 + 4 * fq);
                            u32x4 bk; bk.x = lo.x; bk.y = lo.y; bk.z = hi.x; bk.w = hi.y;
                            yacc[pt] = __builtin_amdgcn_mfma_f32_16x16x32_bf16(__builtin_bit_cast(bf16x8, bk), a, yacc[pt], 0, 0, 0); } } }
                bf16_t* yrow = YP + (size_t)(r0 + 16 * w + fr) * 2048 + g * 512 + hh * 64 + 4 * fq;
#pragma unroll
                for (int pt = 0; pt < 4; ++pt) { u32x2 pk; pk.x = pk_bf16(yacc[pt][0], yacc[pt][1]); pk.y = pk_bf16(yacc[pt][2], yacc[pt][3]); *(u32x2*)(yrow + 16 * pt) = pk; }
            }
            {
                f32x4 zacc[4];
#pragma unroll
                for (int pt = 0; pt < 4; ++pt) zacc[pt] = (f32x4){0.f, 0.f, 0.f, 0.f};
#pragma unroll
                for (int kk = 0; kk < 4; ++kk) { const bf16x8 bfr = *(const bf16x8*)(sBt + (16 * w + fr) * LS + 32 * kk + 8 * fq);
#pragma unroll
                    for (int pt = 0; pt < 4; ++pt) { const bf16x8 xa = *(const bf16x8*)(Xdt_c + (16 * pt + fr) * LS + 32 * kk + 8 * fq);
                        zacc[pt] = __builtin_amdgcn_mfma_f32_16x16x32_bf16(bfr, xa, zacc[pt], 0, 0, 0); } }
                bf16_t* sp = ST + ((size_t)((bl * 32 + c) * 32 + h)) * 8192 + fr * 128 + 16 * w + 4 * fq;
#pragma unroll
                for (int pt = 0; pt < 4; ++pt) { u32x2 pk; pk.x = pk_bf16(zacc[pt][0], zacc[pt][1]); pk.y = pk_bf16(zacc[pt][2], zacc[pt][3]); *(u32x2*)(sp + (16 * pt) * 128) = pk; }
            }
            __syncthreads();
        }
#undef SSDA_CONVX
    }
}

__device__ __forceinline__ void ssdB_phase(const Params& p, unsigned char* gws, int bid, int nblk, int l) {
    int tid_ = threadIdx.x; asm volatile("" : "+v"(tid_));
    const int gtid = bid * 512 + tid_, nthr = nblk * 512;
    bf16_t* ST = (bf16_t*)(gws + OFF_ST); const float* CD = (const float*)(gws + OFF_CD);
    for (int idx = gtid; idx < SB * 32 * 64 * 16; idx += nthr) {
        const int n8 = idx & 15, pp = (idx >> 4) & 63, h = (idx >> 10) & 31, bl = idx >> 15;
        bf16_t* base = ST + ((size_t)(bl * 32 * 32 + h)) * 8192 + pp * 128 + n8 * 8;
        float hr[8];
#pragma unroll
        for (int j = 0; j < 8; ++j) hr[j] = 0.f;
#pragma unroll 1
        for (int c0 = 0; c0 < 32; c0 += 8) {
            u32x4 sv[8];
#pragma unroll
            for (int cc = 0; cc < 8; ++cc) sv[cc] = __builtin_nontemporal_load((const u32x4*)(base + (size_t)(c0 + cc) * 32 * 8192));
#pragma unroll
            for (int cc = 0; cc < 8; ++cc) { const float d = CD[(bl * 32 + c0 + cc) * 32 + h];
                u32x4 o; o.x = pk_bf16(hr[0], hr[1]); o.y = pk_bf16(hr[2], hr[3]); o.z = pk_bf16(hr[4], hr[5]); o.w = pk_bf16(hr[6], hr[7]);
                *(u32x4*)(base + (size_t)(c0 + cc) * 32 * 8192) = o;
                hr[0] = hr[0] * d + bf_lo(sv[cc].x); hr[1] = hr[1] * d + bf_hi(sv[cc].x); hr[2] = hr[2] * d + bf_lo(sv[cc].y); hr[3] = hr[3] * d + bf_hi(sv[cc].y);
                hr[4] = hr[4] * d + bf_lo(sv[cc].z); hr[5] = hr[5] * d + bf_hi(sv[cc].z); hr[6] = hr[6] * d + bf_lo(sv[cc].w); hr[7] = hr[7] * d + bf_hi(sv[cc].w); }
        }
    }
    const bf16_t* CHB = (const bf16_t*)(gws + OFF_CHB); bf16_t* SCB = (bf16_t*)(gws + OFF_SCB);
    const float* scw = p.in[14] + (size_t)l * 3 * 1024;
    for (int idx = gtid; idx < (MS / 16) * 128; idx += nthr) {
        const int cgp = idx & 127, run = idx >> 7; const int r = run * 16, ch = cgp * 8; const bool first = (r & 4095) == 0;
        float w0[8], w1[8], w2[8];
#pragma unroll
        for (int j = 0; j < 8; ++j) { w0[j] = scw[ch + j]; w1[j] = scw[1024 + ch + j]; w2[j] = scw[2048 + ch + j]; }
        u32x4 p2 = (u32x4){0u, 0u, 0u, 0u}, p1 = p2;
        if (!first) { p2 = *(const u32x4*)(CHB + (size_t)(r - 2) * 1024 + ch); p1 = *(const u32x4*)(CHB + (size_t)(r - 1) * 1024 + ch); }
#pragma unroll 1
        for (int i0 = 0; i0 < 16; i0 += 8) {
            u32x4 cv[8], bv[8];
#pragma unroll
            for (int i = 0; i < 8; ++i) { cv[i] = __builtin_nontemporal_load((const u32x4*)(CHB + (size_t)(r + i0 + i) * 1024 + ch)); bv[i] = __builtin_nontemporal_load((const u32x4*)(SCB + (size_t)(r + i0 + i) * 1024 + ch)); }
#pragma unroll
            for (int i = 0; i < 8; ++i) { float o[8];
#define SC1(j, P2, P1, CU, BB, LOHI) o[j] = LOHI(BB) * (w0[j] * LOHI(P2) + w1[j] * LOHI(P1) + w2[j] * LOHI(CU));
                SC1(0, p2.x, p1.x, cv[i].x, bv[i].x, bf_lo) SC1(1, p2.x, p1.x, cv[i].x, bv[i].x, bf_hi) SC1(2, p2.y, p1.y, cv[i].y, bv[i].y, bf_lo) SC1(3, p2.y, p1.y, cv[i].y, bv[i].y, bf_hi)
                SC1(4, p2.z, p1.z, cv[i].z, bv[i].z, bf_lo) SC1(5, p2.z, p1.z, cv[i].z, bv[i].z, bf_hi) SC1(6, p2.w, p1.w, cv[i].w, bv[i].w, bf_lo) SC1(7, p2.w, p1.w, cv[i].w, bv[i].w, bf_hi)
#undef SC1
                u32x4 ov; ov.x = pk_bf16(o[0], o[1]); ov.y = pk_bf16(o[2], o[3]); ov.z = pk_bf16(o[4], o[5]); ov.w = pk_bf16(o[6], o[7]);
                *(u32x4*)(SCB + (size_t)(r + i0 + i) * 1024 + ch) = ov;
                p2 = p1; p1 = cv[i]; }
        }
    }
}

__device__ __forceinline__ void ssdC_phase(const Params& p, unsigned char* gws, int bid, int nblk, int l, unsigned char* smem) {
    int tid_ = threadIdx.x; asm volatile("" : "+v"(tid_));
    const int tid = tid_, lane = tid & 63, w = tid >> 6, fr = lane & 15, fq = lane >> 4;
    bf16_t* sC = (bf16_t*)smem; bf16_t* sPrev = sC + 128 * LS; float* sAcs = (float*)(smem + (128 + 64) * LS * 2);
    const bf16_t* XBC = (const bf16_t*)(gws + OFF_XBC); const float* DT = (const float*)(gws + OFF_DT);
    const bf16_t* YP = (const bf16_t*)(gws + OFF_YP); const bf16_t* ST = (const bf16_t*)(gws + OFF_ST); const bf16_t* Z = (const bf16_t*)(gws + OFF_Z);
    bf16_t* SSDN = (bf16_t*)(gws + OFF_SSDN);
    const float* cw = p.in[7] + (size_t)l * 4 * 3072; const float* cb = p.in[8] + l * 3072;
    const float* a_log = p.in[10] + l * 32; const float* ng = p.in[12] + l * 2048;
    for (int item = bid; item < SB * 32 * 4; item += nblk) {
        const int bl = item >> 7, c = (item >> 2) & 31, g = item & 3; const int r0 = bl * 4096 + c * 128; const bool first = (c == 0);
        ssd_acs(DT, a_log, r0, g, sAcs, nullptr, nullptr);
        if (tid < 256) {
            const int l0 = (tid >> 4) * 8, n0 = (tid & 15) * 8; const int col = 2048 + 512 + g * 128 + n0;
            float o[8][8]; conv_rows8<8>(XBC, cw, cb, r0, l0, col, first, o);
#pragma unroll
            for (int i = 0; i < 8; ++i) { u32x4 v; v.x = pk_bf16(o[i][0], o[i][1]); v.y = pk_bf16(o[i][2], o[i][3]); v.z = pk_bf16(o[i][4], o[i][5]); v.w = pk_bf16(o[i][6], o[i][7]);
                *(u32x4*)(sC + (l0 + i) * LS + n0) = v; }
        }
        __syncthreads();
        bf16x8 ca[4];
#pragma unroll
        for (int kk = 0; kk < 4; ++kk) ca[kk] = *(const bf16x8*)(sC + (16 * w + fr) * LS + 32 * kk + 8 * fq);
        const int lrow = 16 * w + fr;
        u32x2 y[8][4]; float ss = 0.f;
        const int prow_ = tid >> 3, pseg_ = (tid & 7) * 16; const bf16_t* psrc = ST + ((size_t)((bl * 32 + c) * 32 + g * 8)) * 8192 + prow_ * 128 + pseg_;
        u32x4 nv0 = *(const u32x4*)psrc, nv1 = *(const u32x4*)(psrc + 8);
#pragma unroll
        for (int hh = 0; hh < 8; ++hh) {
            const size_t off = (size_t)(r0 + lrow) * 2048 + g * 512 + hh * 64 + 4 * fq;
            u32x2 ypq[4], zzq[4];
            {
                const u32x4 v0 = nv0, v1 = nv1;
                if (hh < 7) { nv0 = *(const u32x4*)(psrc + (size_t)(hh + 1) * 8192); nv1 = *(const u32x4*)(psrc + (size_t)(hh + 1) * 8192 + 8); }
#pragma unroll
                for (int pt = 0; pt < 4; ++pt) { ypq[pt] = *(const u32x2*)(YP + off + 16 * pt); zzq[pt] = *(const u32x2*)(Z + off + 16 * pt); }
                __syncthreads();
                *(u32x4*)(sPrev + prow_ * LS + pseg_) = v0; *(u32x4*)(sPrev + prow_ * LS + pseg_ + 8) = v1;
                __syncthreads();
            }
            f32x4 acc[4];
#pragma unroll
            for (int pt = 0; pt < 4; ++pt) acc[pt] = (f32x4){0.f, 0.f, 0.f, 0.f};
#pragma unroll
            for (int kk = 0; kk < 4; ++kk)
#pragma unroll
                for (int pt = 0; pt < 4; ++pt) { const bf16x8 b = *(const bf16x8*)(sPrev + (16 * pt + fr) * LS + 32 * kk + 8 * fq);
                    acc[pt] = __builtin_amdgcn_mfma_f32_16x16x32_bf16(b, ca[kk], acc[pt], 0, 0, 0); }
            const float el = __expf(sAcs[hh * 128 + lrow]);
#pragma unroll
            for (int pt = 0; pt < 4; ++pt) { const u32x2 yp = ypq[pt], zz = zzq[pt];
                f32x4 v; v[0] = (el * acc[pt][0] + bf_lo(yp.x)) * bf_lo(zz.x); v[1] = (el * acc[pt][1] + bf_hi(yp.x)) * bf_hi(zz.x);
                v[2] = (el * acc[pt][2] + bf_lo(yp.y)) * bf_lo(zz.y); v[3] = (el * acc[pt][3] + bf_hi(yp.y)) * bf_hi(zz.y);
                u32x2 yk; yk.x = pk_bf16(v[0], v[1]); yk.y = pk_bf16(v[2], v[3]); y[hh][pt] = yk; ss += v[0] * v[0] + v[1] * v[1] + v[2] * v[2] + v[3] * v[3]; }
        }
        ss += __shfl_xor(ss, 16); ss += __shfl_xor(ss, 32);
        const float rinv = rsqrtf(ss * (1.0f / 512.0f) + EPS);
#pragma unroll
        for (int hh = 0; hh < 8; ++hh)
#pragma unroll
            for (int pt = 0; pt < 4; ++pt) { const int colg = g * 512 + hh * 64 + 16 * pt + 4 * fq; const f32x4 gg = *(const f32x4*)(ng + colg); const u32x2 yk = y[hh][pt]; f32x4 v; v[0] = bf_lo(yk.x) * rinv * gg[0]; v[1] = bf_hi(yk.x) * rinv * gg[1]; v[2] = bf_lo(yk.y) * rinv * gg[2]; v[3] = bf_hi(yk.y) * rinv * gg[3];
                u32x2 pk; pk.x = pk_bf16(v[0], v[1]); pk.y = pk_bf16(v[2], v[3]);
                *(u32x2*)(SSDN + (size_t)(r0 + lrow) * 2048 + colg) = pk; }
        __syncthreads();
    }
}

__device__ __forceinline__ void ffnact_phase(const Params& p, unsigned char* gws, int bid, int nblk, int l) {
    int tid_ = threadIdx.x; asm volatile("" : "+v"(tid_));
    const int gtid = bid * 512 + tid_, nthr = nblk * 512;
    const bf16_t* U = (const bf16_t*)(gws + OFF_U); bf16_t* ACT = (bf16_t*)(gws + OFF_ACT);
    const float* fw = p.in[20] + (size_t)l * 3 * 5632; const float* fb = p.in[21] + (size_t)l * 5632;
    constexpr int RUN = 90, NRUN = (MS + RUN - 1) / RUN;
    for (int idx = gtid; idx < NRUN * 352; idx += nthr) {
        const int run = idx / 352, cgp = idx - run * 352; const int r = run * RUN, ch = cgp * 8; const int rend = (r + RUN < MS) ? r + RUN : MS;
        float wg0[8], wg1[8], wg2[8], bg[8], wv0[8], wv1[8], wv2[8], bv[8];
#pragma unroll
        for (int j = 0; j < 8; ++j) { wg0[j] = fw[ch + j]; wg1[j] = fw[5632 + ch + j]; wg2[j] = fw[2 * 5632 + ch + j]; bg[j] = fb[ch + j];
            wv0[j] = fw[2816 + ch + j]; wv1[j] = fw[5632 + 2816 + ch + j]; wv2[j] = fw[2 * 5632 + 2816 + ch + j]; bv[j] = fb[2816 + ch + j]; }
        u32x4 g2 = (u32x4){0u, 0u, 0u, 0u}, g1 = g2, v2 = g2, v1 = g2;
        if ((r & 4095) >= 2) { g2 = *(const u32x4*)(U + (size_t)(r - 2) * 5632 + ch); v2 = *(const u32x4*)(U + (size_t)(r - 2) * 5632 + 2816 + ch); }
        if ((r & 4095) >= 1) { g1 = *(const u32x4*)(U + (size_t)(r - 1) * 5632 + ch); v1 = *(const u32x4*)(U + (size_t)(r - 1) * 5632 + 2816 + ch); }
#pragma unroll 1
        for (int t0 = r; t0 < rend; t0 += 6) {
            u32x4 gv[6], vv[6];
#pragma unroll
            for (int i = 0; i < 6; ++i) { const int t = (t0 + i < rend) ? t0 + i : rend - 1; gv[i] = *(const u32x4*)(U + (size_t)t * 5632 + ch); vv[i] = *(const u32x4*)(U + (size_t)t * 5632 + 2816 + ch); }
#pragma unroll
            for (int i = 0; i < 6; ++i) { const int t = t0 + i; if (t < rend) {
                if ((t & 4095) == 0) { g2 = (u32x4){0u, 0u, 0u, 0u}; g1 = g2; v2 = g2; v1 = g2; } else if ((t & 4095) == 1) { g2 = (u32x4){0u, 0u, 0u, 0u}; v2 = g2; }
                float o[8];
#define FF1(j, A2, A1, AC, B2, B1, BC, LOHI) { const float ug = bg[j] + wg0[j] * LOHI(A2) + wg1[j] * LOHI(A1) + wg2[j] * LOHI(AC); const float uv = bv[j] + wv0[j] * LOHI(B2) + wv1[j] * LOHI(B1) + wv2[j] * LOHI(BC); o[j] = fsilu(ug) * uv; }
                FF1(0, g2.x, g1.x, gv[i].x, v2.x, v1.x, vv[i].x, bf_lo) FF1(1, g2.x, g1.x, gv[i].x, v2.x, v1.x, vv[i].x, bf_hi)
                FF1(2, g2.y, g1.y, gv[i].y, v2.y, v1.y, vv[i].y, bf_lo) FF1(3, g2.y, g1.y, gv[i].y, v2.y, v1.y, vv[i].y, bf_hi)
                FF1(4, g2.z, g1.z, gv[i].z, v2.z, v1.z, vv[i].z, bf_lo) FF1(5, g2.z, g1.z, gv[i].z, v2.z, v1.z, vv[i].z, bf_hi)
                FF1(6, g2.w, g1.w, gv[i].w, v2.w, v1.w, vv[i].w, bf_lo) FF1(7, g2.w, g1.w, gv[i].w, v2.w, v1.w, vv[i].w, bf_hi)
#undef FF1
                u32x4 ov; ov.x = pk_bf16(o[0], o[1]); ov.y = pk_bf16(o[2], o[3]); ov.z = pk_bf16(o[4], o[5]); ov.w = pk_bf16(o[6], o[7]);
                *(u32x4*)(ACT + (size_t)t * 2816 + ch) = ov;
                g2 = g1; g1 = gv[i]; v2 = v1; v1 = vv[i]; } }
        }
    }
}

#define XB_TMO      128
#define XB_XCNT(j)  (256  + 64 * (j))
#define XB_XSUB(j)  (1280 + 64 * (j))
#define XB_XGEN(j)  (2304 + 64 * (j))
#define XB_TOP      3328
#define XB_TOPGEN   3392
#define XCD_BAR_WORDS 3456
#define XB_SPIN_CAP (1u << 22)
__device__ __forceinline__ unsigned xb_ld(unsigned* p)              { return __hip_atomic_load(p, __ATOMIC_RELAXED, __HIP_MEMORY_SCOPE_AGENT); }
__device__ __forceinline__ unsigned xb_add(unsigned* p, unsigned v) { return __hip_atomic_fetch_add(p, v, __ATOMIC_RELAXED, __HIP_MEMORY_SCOPE_AGENT); }
__device__ __forceinline__ unsigned xb_xcc_id() { return (unsigned)__builtin_amdgcn_s_getreg((3 << 11) | 20) & 0xFu; }
#define XB_SPIN(cond, bar) do { unsigned _sp = 0; while (cond) { __builtin_amdgcn_s_sleep(1); \
    if ((++_sp & 255u) == 0u) { if (xb_ld(&(bar)[XB_TMO])) break; if (_sp > XB_SPIN_CAP) { atomicAdd(&(bar)[XB_TMO], 1u); break; } } } } while (0)
struct XcdBarrier { unsigned* bar; unsigned x; unsigned G; volatile LAS unsigned* st; };
__device__ __forceinline__ XcdBarrier xcd_barrier_post(unsigned* bar, volatile LAS unsigned* st, unsigned G) {
    XcdBarrier b; b.bar = bar; b.x = xb_xcc_id(); b.st = st; b.G = G;
    if (threadIdx.x == 0) (void)xb_add(&bar[XB_XCNT(b.x)], 1u);
    return b;
}
__device__ __forceinline__ void xcd_barrier_complete(unsigned* bar, unsigned x, unsigned G, unsigned& nloc, unsigned& nx) {
    unsigned sum, cnt, mine, sp = 0u;
    for (;;) {
        sum = 0u; cnt = 0u; mine = 0u;
#pragma unroll
        for (unsigned j = 0; j < 16; ++j) { const unsigned c = xb_ld(&bar[XB_XCNT(j)]); sum += c; cnt += (c > 0u) ? 1u : 0u; mine = (j == x) ? c : mine; }
        if (sum == G) break;
        __builtin_amdgcn_s_sleep(1);
        if ((++sp & 255u) == 0u) { if (xb_ld(&bar[XB_TMO])) break; if (sp > XB_SPIN_CAP) { atomicAdd(&bar[XB_TMO], 1u); break; } }
    }
    nloc = mine > 0u ? mine : 1u; nx = cnt > 0u ? cnt : 1u;
}
__device__ __forceinline__ void xcd_barrier(const XcdBarrier& b) {
    asm volatile("s_waitcnt vmcnt(0)" ::: "memory");
    __syncthreads();
    if (threadIdx.x == 0) {
        unsigned* bar = b.bar;
        __builtin_amdgcn_s_waitcnt(0);
        unsigned nloc = b.st[0], nx = b.st[1];
        if (nloc == 0u) { xcd_barrier_complete(bar, b.x, b.G, nloc, nx); b.st[0] = nloc; b.st[1] = nx; }
        const unsigned old = xb_add(&bar[XB_XSUB(b.x)], 1u);
        const unsigned gen = old / nloc;
        if (old + 1u == (gen + 1u) * nloc) {
            __builtin_amdgcn_fence(__ATOMIC_RELEASE, "agent");
            asm volatile("s_waitcnt vmcnt(0)" ::: "memory");
            if (nx > 1u) {
                const unsigned og = xb_add(&bar[XB_TOP], 1u);
                const unsigned tg = og / nx;
                if (og + 1u == (tg + 1u) * nx) xb_add(&bar[XB_TOPGEN], 1u);
                else XB_SPIN(xb_ld(&bar[XB_TOPGEN]) == tg, bar);
            }
            __builtin_amdgcn_fence(__ATOMIC_ACQUIRE, "agent");
            xb_add(&bar[XB_XGEN(b.x)], 1u);
            asm volatile("s_waitcnt vmcnt(0)" ::: "memory");
        } else {
            XB_SPIN(xb_ld(&bar[XB_XGEN(b.x)]) == gen, bar);
            __builtin_amdgcn_fence(__ATOMIC_ACQUIRE, "agent");
            asm volatile("s_waitcnt vmcnt(0)" ::: "memory");
        }
    }
    __syncthreads();
}

__device__ __forceinline__ void dt_phase(const bf16_t* __restrict__ Hh, const bf16_t* __restrict__ Wd, const float* __restrict__ dt_bias, float* __restrict__ DT, int bid, int nblk) {
    int tid_ = threadIdx.x; asm volatile("" : "+v"(tid_));
    const int lane = tid_ & 63, w = tid_ >> 6, fr = lane & 15, fq = lane >> 4;
    for (int u = bid; u < MS / 128; u += nblk) {
        const int row = u * 128 + 16 * w + fr;
        const bf16_t* ap = Hh + (size_t)row * 1024 + 8 * fq; const bf16_t* bp0 = Wd + (size_t)fr * 1024 + 8 * fq; const bf16_t* bp1 = bp0 + 16 * 1024;
        f32x4 acc0 = (f32x4){0.f, 0.f, 0.f, 0.f}, acc1 = acc0;
#pragma unroll 1
        for (int k0 = 0; k0 < 32; k0 += 8) {
            bf16x8 a[8], b0[8], b1[8];
#pragma unroll
            for (int k = 0; k < 8; ++k) { a[k] = *(const bf16x8*)(ap + 32 * (k0 + k)); b0[k] = *(const bf16x8*)(bp0 + 32 * (k0 + k)); b1[k] = *(const bf16x8*)(bp1 + 32 * (k0 + k)); }
#pragma unroll
            for (int k = 0; k < 8; ++k) { acc0 = __builtin_amdgcn_mfma_f32_16x16x32_bf16(b0[k], a[k], acc0, 0, 0, 0); acc1 = __builtin_amdgcn_mfma_f32_16x16x32_bf16(b1[k], a[k], acc1, 0, 0, 0); }
        }
        const int h0 = 8 * fq; f32x4 o0, o1;
#pragma unroll
        for (int e = 0; e < 4; ++e) { const float x0 = acc0[e] + dt_bias[h0 + e], x1 = acc1[e] + dt_bias[h0 + 4 + e];
            o0[e] = x0 > 20.f ? x0 : log1pf(expf(x0)); o1[e] = x1 > 20.f ? x1 : log1pf(expf(x1)); }
        *(f32x4*)(DT + (size_t)row * 32 + h0) = o0; *(f32x4*)(DT + (size_t)row * 32 + h0 + 4) = o1;
    }
}

__global__ void __launch_bounds__(512) fwd_megakernel(Params p) {
    extern __shared__ __attribute__((aligned(16))) unsigned char smem[];
    cg::grid_group grid = cg::this_grid();
    LAS unsigned char* lds = (LAS unsigned char*)smem;
    const int bx = blockIdx.x;
    const int grp = (bx & 7) / XPG;
    const int bid = (bx >> 3) * XPG + (bx & 7) % XPG;
    const int nblk = GBLK;
    unsigned char* ws = p.ws;
    unsigned char* gws = ws + OFF_GRP + (size_t)grp * GSTRIDE;
    volatile LAS unsigned* xst = (volatile LAS unsigned*)(lds + 131072);
    if (threadIdx.x == 0) { xst[0] = 0u; xst[1] = 0u; }
    __syncthreads();
    static_assert(NGRP * 16384 <= BAR_BYTES, "barrier words");
    if (bx < NGRP) { unsigned* bw = (unsigned*)(ws + OFF_BAR + (size_t)bx * 16384); for (int i = threadIdx.x; i < 4096; i += 512) bw[i] = 0u; }
    const float* modb = (const float*)(ws + OFF_MOD);
    bf16_t* H = (bf16_t*)(gws + OFF_H);
    pg8::StaticOrder S;

    prep_phase(p, (float*)smem, 0, bx, (int)gridDim.x);
    prep_phase(p, (float*)smem, 1, bx, (int)gridDim.x);
    grid.sync();
    XcdBarrier xb = xcd_barrier_post((unsigned*)(ws + OFF_BAR + (size_t)grp * 16384), xst, (unsigned)nblk);
#define BAR_() xcd_barrier(xb)
#pragma unroll 1
    for (int si = 0; si < NSL / NGRP; ++si) {
#pragma unroll 1
        for (int l = 0; l < DEPTH; ++l) {
            int sl = grp + NGRP * si;
            asm volatile("" : "+s"(l), "+s"(sl));
#define mod (modb + (size_t)l * 16 * 6144)
#define mod1 (modb + (size_t)16 * 6144)
#define wt ((const bf16_t*)(ws + OFF_WT) + (size_t)l * E_WLAYER)
#define row0 (sl * MS)
#define LAUNDER() asm volatile("" : "+s"(l), "+s"(sl))
            if (l == 0 && si == 0) {
                resnorm_phase<false, true>(p.in[0], nullptr, nullptr, H, nullptr, nullptr, p.in[4], mod + 1024, mod, row0, bid, nblk);
                BAR_(); LAUNDER();
            }
            { pg8::Gemm g{H, wt + E_WIN, MS, NPI - 256, 1024}; S.init(MS, NPI - 256, nblk, bid);
              EpiInProj E{(bf16_t*)(gws + OFF_Z), (bf16_t*)(gws + OFF_XBC), (bf16_t*)(gws + OFF_SCB), (bf16_t*)(gws + OFF_CHB), (bf16_t*)(gws + OFF_G), (float*)(gws + OFF_DT), p.in[9] + l * 32};
              pg8::gemm_phase(lds, g, S, E); }
            dt_phase(H, wt + E_WIN + (size_t)(NPI - 256) * 1024, p.in[9] + l * 32, (float*)(gws + OFF_DT), bid, nblk);
            BAR_(); LAUNDER();
            ssdA_phase(p, gws, bid, nblk, l, smem);
            BAR_(); LAUNDER();
            ssdB_phase(p, gws, bid, nblk, l);
            BAR_(); LAUNDER();
            ssdC_phase(p, gws, bid, nblk, l, smem);
            LAUNDER();
            { pg8::Gemm g{(const bf16_t*)(gws + OFF_SCPRE), wt + E_WSC, MS, 1024, 1024}; S.init(MS, 1024, nblk, bid);
              EpiGate1 E{(bf16_t*)(gws + OFF_T1), (const bf16_t*)(gws + OFF_G) + 1024}; pg8::gemm_phase(lds, g, S, E); }
            BAR_(); LAUNDER();
            { pg8::Gemm g{(const bf16_t*)(gws + OFF_SSDN), wt + E_WSSD, MS, 1024, 2048}; S.init(MS, 1024, nblk, bid);
              EpiGate2 E{(bf16_t*)(gws + OFF_MIXIN), (const bf16_t*)(gws + OFF_T1), (const bf16_t*)(gws + OFF_G)}; pg8::gemm_phase(lds, g, S, E); }
            BAR_(); LAUNDER();
            { pg8::Gemm g{(const bf16_t*)(gws + OFF_MIXIN), wt + E_WO, MS, 1024, 1024}; S.init(MS, 1024, nblk, bid);
              EpiBf16 E{(bf16_t*)(gws + OFF_MIX), 1024}; pg8::gemm_phase(lds, g, S, E); }
            BAR_(); LAUNDER();
            if (l == 0) resnorm_phase<true, true, false, true>(p.in[0], (const bf16_t*)(gws + OFF_MIX), p.out, H, mod + 2048, p.in[5] + l * 1024, p.in[17] + l * 1024, mod + 4096, mod + 3072, row0, bid, nblk);
            else resnorm_phase<true, true, true, true>(p.out, (const bf16_t*)(gws + OFF_MIX), p.out, H, mod + 2048, p.in[5] + l * 1024, p.in[17] + l * 1024, mod + 4096, mod + 3072, row0, bid, nblk);
            BAR_(); LAUNDER();
            { constexpr int NMT = (MS + 247) / 248;
              pg8::Gemm g{H, wt + E_WUP, NMT * 256, 5632, 1024}; S.init(NMT * 256, 5632, nblk, bid);
              EpiFfn E{(bf16_t*)(gws + OFF_ACT), p.in[20] + (size_t)l * 3 * 5632, p.in[21] + (size_t)l * 5632}; pg8::gemm_phase<EpiFfn, true>(lds, g, S, E); }
            BAR_(); LAUNDER();
            { pg8::Gemm g{(const bf16_t*)(gws + OFF_ACT), wt + E_WDN, MS, 1024, 2816}; S.init(MS, 1024, nblk, bid);
              EpiBf16 E{(bf16_t*)(gws + OFF_F), 1024}; pg8::gemm_phase(lds, g, S, E); }
            BAR_(); LAUNDER();
            if (l == 0) {
                resnorm_phase<true, true, true, true>(p.out, (const bf16_t*)(gws + OFF_F), p.out, H, mod + 5120, p.in[18] + l * 1024, p.in[4] + 1024, mod1 + 1024, mod1, row0, bid, nblk);
            } else {
                resnorm_phase<true, false, true, false>(p.out, (const bf16_t*)(gws + OFF_F), p.out, nullptr, mod + 5120, p.in[18] + l * 1024, nullptr, nullptr, nullptr, row0, bid, nblk);
                if (si + 1 < NSL / NGRP)
                    resnorm_phase<false, true>(p.in[0], nullptr, nullptr, H, nullptr, nullptr, p.in[4], modb + 1024, modb, (sl + NGRP) * MS, bid, nblk);
            }
            if (!(l == DEPTH - 1 && si + 1 == NSL / NGRP)) { BAR_(); }
            LAUNDER();
        }
    }
#undef mod
#undef mod1
#undef wt
#undef row0
#undef LAUNDER
#undef BAR_
}

extern "C" void kernel_launch(void* const* d_in, const int* in_sizes, int n_in, void* d_out, int out_size, void* d_ws, size_t ws_size, hipStream_t stream) {
    static int grid_blocks = 0;
    if (grid_blocks == 0) {
        if (n_in != 23 || ws_size < WS_NEED) { fprintf(stderr, "kernel_launch: need 23 inputs and %zu B workspace, got %d / %zu\n", (size_t)WS_NEED, n_in, ws_size); grid_blocks = -1; return; }
        int dev = 0, cus = 0, per_cu = 0;
        (void)hipGetDevice(&dev);
        (void)hipDeviceGetAttribute(&cus, hipDeviceAttributeMultiprocessorCount, dev);
        if (hipFuncSetAttribute((const void*)fwd_megakernel, hipFuncAttributeMaxDynamicSharedMemorySize, LDS_BYTES) != hipSuccess) { fprintf(stderr, "kernel_launch: hipFuncSetAttribute failed\n"); grid_blocks = -1; return; }
        if (hipOccupancyMaxActiveBlocksPerMultiprocessor(&per_cu, (const void*)fwd_megakernel, 512, LDS_BYTES) != hipSuccess || per_cu < 1) { fprintf(stderr, "kernel_launch: occupancy query failed (%d)\n", per_cu); (void)hipGetLastError(); }
        if (cus < NGRP * GBLK) { fprintf(stderr, "kernel_launch: built for %d CUs, device has %d\n", NGRP * GBLK, cus); grid_blocks = -1; return; }
        grid_blocks = NGRP * GBLK;
    }
    if (grid_blocks < 0) return;
    Params p{};
    for (int i = 0; i < 23; ++i) p.in[i] = (const float*)d_in[i];
    p.out = (float*)d_out; p.ws = (unsigned char*)d_ws;
    p.ph_lo = 0; p.ph_hi = 0;
    void* args[] = {&p};
    hipError_t e = hipLaunchCooperativeKernel((const void*)fwd_megakernel, dim3(grid_blocks), dim3(512), args, LDS_BYTES, stream);
    if (e != hipSuccess) fprintf(stderr, "cooperative launch failed: %s (grid %d)\n", hipGetErrorString(e), grid_blocks);
}
```
